# Optimizing an MI355X kernel written in HIP

```python
import jax, jax.numpy as jnp
from jax import lax
import numpy as np

D_MODEL = 2048
BATCH = 8
SEQ = 2048
DEPTH = 1

CHUNK = 64
EPS = 1e-6

POOL_WINDOWS = (2, 4, 8, 16)
POOL_GROUPS = len(POOL_WINDOWS)
POOL_WIDTH = D_MODEL // 2
POOL_GROUP = POOL_WIDTH // POOL_GROUPS
POOL_OUT_GROUP = D_MODEL // POOL_GROUPS

GLA_HEADS = 4
GLA_DK = D_MODEL // 2 // GLA_HEADS
GLA_DV = D_MODEL // GLA_HEADS
QK_WIDTH = GLA_HEADS * GLA_DK
V_WIDTH = GLA_HEADS * GLA_DV
GATE_RANK = 16
GATE_TAU = 16.0

N_BRANCHES = 2
GATE_WIDTH = N_BRANCHES * D_MODEL

D_FF = 4 * D_MODEL

SPLITS = (
    POOL_WIDTH,
    POOL_WIDTH + QK_WIDTH,
    POOL_WIDTH + 2 * QK_WIDTH,
    POOL_WIDTH + 2 * QK_WIDTH + V_WIDTH,
    POOL_WIDTH + 2 * QK_WIDTH + 2 * V_WIDTH,
    POOL_WIDTH + 2 * QK_WIDTH + 2 * V_WIDTH + GATE_RANK,
)
IN_WIDTH = POOL_WIDTH + 2 * QK_WIDTH + 2 * V_WIDTH + GATE_RANK + GATE_WIDTH

kernel_name = "hybrid_pool_gla_gated_block"


def rmsnorm(x, g):
    xf = x.astype(jnp.float32)
    y = xf * lax.rsqrt(jnp.mean(xf * xf, axis=-1, keepdims=True) + EPS)
    return (y * g.astype(jnp.float32)).astype(x.dtype)


def pool_mixer(u, w_groups, scale):
    b, s, _ = u.shape
    uf = u.astype(jnp.float32)
    csum = jnp.cumsum(uf, axis=1)
    count = jnp.arange(1, s + 1, dtype=jnp.float32)[None, :, None]
    diffs = []
    for gi, w in enumerate(POOL_WINDOWS):
        sl = slice(gi * POOL_GROUP, (gi + 1) * POOL_GROUP)
        cg = csum[..., sl]
        c_prev = jnp.pad(cg, ((0, 0), (w, 0), (0, 0)))[:, :s]
        mean = (cg - c_prev) / jnp.minimum(count, float(w))
        diffs.append(mean - uf[..., sl])
    d = jnp.stack(diffs, axis=2).astype(u.dtype)
    y = jnp.einsum('bsgc,gce->bsge', d, w_groups).reshape(b, s, D_MODEL)
    return y * scale


def gla_mixer(q, k, v, g, a_low, w_alpha, b_alpha, norm_g):
    b, s, _ = q.shape
    nc = s // CHUNK
    log_a = jax.nn.log_sigmoid((a_low @ w_alpha + b_alpha).astype(jnp.float32)) / GATE_TAU

    def chunked(t, d):
        return t.astype(jnp.float32).reshape(b, nc, CHUNK, GLA_HEADS, d).transpose(1, 0, 3, 2, 4)

    qc = chunked(q, GLA_DK) * (GLA_DK ** -0.5)
    kc = chunked(k, GLA_DK)
    vc = chunked(v, GLA_DV)
    cum = jnp.cumsum(chunked(log_a, GLA_DK), axis=3)
    last = cum[:, :, :, -1:, :]
    k_dec = kc * jnp.exp(last - cum)
    chunk_decay = jnp.exp(last[:, :, :, 0, :])

    def step(state, inp):
        q_c, k_c, v_c, a_c = inp
        state = a_c[..., None] * state + jnp.einsum('bhcd,bhce->bhde', k_c, v_c)
        return state, jnp.einsum('bhcd,bhde->bhce', q_c, state)

    s0 = jnp.zeros((b, GLA_HEADS, GLA_DK, GLA_DV), jnp.float32)
    _, o = lax.scan(step, s0, (qc, k_dec, vc, chunk_decay))
    o = o.transpose(1, 0, 3, 2, 4).reshape(b, s, GLA_HEADS, GLA_DV)
    o = o * lax.rsqrt(jnp.mean(o * o, axis=-1, keepdims=True) + EPS) * norm_g.astype(jnp.float32)
    o = o.reshape(b, s, V_WIDTH) * jax.nn.silu(g.astype(jnp.float32))
    return o.astype(q.dtype)


def setup_inputs(seed: int = 0) -> dict:
    key = jax.random.key(seed)
    ks = jax.random.split(key, 16)
    f32 = jnp.float32

    def nrm(k, shape, scale):
        return jax.random.normal(k, shape, f32) * scale

    L = DEPTH
    return {
        "x": jax.random.normal(ks[0], (BATCH, SEQ, D_MODEL), f32),
        "norm_mix_g": 1.0 + nrm(ks[1], (L, D_MODEL), 0.02),
        "w_in": nrm(ks[2], (L, D_MODEL, IN_WIDTH), D_MODEL ** -0.5),
        "pool_w": nrm(ks[3], (L, POOL_GROUPS, POOL_GROUP, POOL_OUT_GROUP), POOL_GROUP ** -0.5),
        "pool_scale": 1.0 + nrm(ks[4], (L, D_MODEL), 0.02),
        "w_alpha": nrm(ks[5], (L, GATE_RANK, QK_WIDTH), GATE_RANK ** -0.5),
        "b_alpha": nrm(ks[6], (L, QK_WIDTH), 0.02),
        "gla_norm_g": 1.0 + nrm(ks[7], (L, GLA_HEADS, GLA_DV), 0.02),
        "w_gla_out": nrm(ks[8], (L, V_WIDTH, D_MODEL), V_WIDTH ** -0.5),
        "w_out": nrm(ks[9], (L, D_MODEL, D_MODEL), D_MODEL ** -0.5),
        "norm_mlp_g": 1.0 + nrm(ks[10], (L, D_MODEL), 0.02),
        "w_mlp_up": nrm(ks[11], (L, D_MODEL, D_FF), D_MODEL ** -0.5),
        "w_mlp_down": nrm(ks[12], (L, D_FF, D_MODEL), D_FF ** -0.5),
        "norm_final_g": 1.0 + nrm(ks[13], (D_MODEL,), 0.02),
    }


def reference(x, norm_mix_g, w_in, pool_w, pool_scale, w_alpha, b_alpha, gla_norm_g,
              w_gla_out, w_out, norm_mlp_g, w_mlp_up, w_mlp_down, norm_final_g):
    for l in range(DEPTH):
        h = rmsnorm(x, norm_mix_g[l])
        proj = h @ w_in[l]
        u, q, k, v, g, a_low, gate_logits = jnp.split(proj, SPLITS, axis=-1)
        y_pool = pool_mixer(u, pool_w[l], pool_scale[l])
        y_gla = gla_mixer(q, k, v, g, a_low, w_alpha[l], b_alpha[l], gla_norm_g[l]) @ w_gla_out[l]
        gate_pool, gate_gla = jnp.split(jax.nn.sigmoid(gate_logits), N_BRANCHES, axis=-1)
        mixed = gate_pool * y_pool + gate_gla * y_gla
        x = x + mixed @ w_out[l]
        h = rmsnorm(x, norm_mlp_g[l])
        x = x + jnp.square(jax.nn.relu(h @ w_mlp_up[l])) @ w_mlp_down[l]
    return rmsnorm(x, norm_final_g)
```

```cpp
#include <hip/hip_runtime.h>
#include <hip/hip_cooperative_groups.h>
#include <cstdio>
#include <cstdint>
namespace cg = cooperative_groups;

#ifndef MK_N_LAUNCHES
#define MK_N_LAUNCHES 1
#endif

#ifndef PROBE_K
#define PROBE_K 0
#endif
#ifndef PROBE_REP
#define PROBE_REP 0
#endif

#define LAS __attribute__((address_space(3)))
typedef unsigned short bf16_t;
typedef short bf16x8 __attribute__((ext_vector_type(8)));
typedef float f32x4 __attribute__((ext_vector_type(4)));
typedef unsigned u32x4 __attribute__((ext_vector_type(4)));
typedef unsigned u32x2 __attribute__((ext_vector_type(2)));

__device__ __forceinline__ unsigned cvt_pk_bf16(float lo, float hi) { unsigned r; asm volatile("v_cvt_pk_bf16_f32 %0, %1, %2" : "=v"(r) : "v"(lo), "v"(hi)); return r; }
__device__ __forceinline__ float bflo(unsigned u) { return __uint_as_float(u << 16); }
__device__ __forceinline__ float bfhi(unsigned u) { return __uint_as_float(u & 0xffff0000u); }
__device__ __forceinline__ float fast_sigmoid(float x) { return __builtin_amdgcn_rcpf(1.0f + __expf(-x)); }
#define LDS_WAIT() asm volatile("s_waitcnt lgkmcnt(0)" ::: "memory")
__device__ __forceinline__ int lane_id() { int r; asm volatile("v_mbcnt_lo_u32_b32 %0, -1, 0\n\tv_mbcnt_hi_u32_b32 %0, -1, %0" : "=v"(r)); return r; }
#define MK_TID(wave_s) ((wave_s) * 64 + lane_id())

namespace pg8 {
constexpr int BM = 256, BK = 64, HALF = 128, HTB = HALF * BK * 2, STAGE_BYTES = 8 * HTB, NXCD = 8, WGM = 8;
__host__ __device__ __forceinline__ int lds_byte(int r, int c) { const int st = (r >> 4) * 2 + (c >> 5), rr = r & 15, cc = c & 31, ob = rr * 64 + cc * 2; return st * 1024 + (ob ^ (((ob >> 9) & 1) << 5)); }
__host__ __device__ __forceinline__ void stage_rc(int b, int& R, int& C) { const int st = b / 1024, sb = b % 1024, swz = sb ^ (((sb >> 9) & 1) << 5); R = (st >> 1) * 16 + swz / 64; C = (st & 1) * 32 + (swz % 64) / 2; }
__host__ __device__ __forceinline__ int perm32(int rho) { const int n = rho >> 4, i = rho & 15; return 8 * (i >> 2) + 4 * n + (i & 3); }

struct Unit { int pm, pn; };
struct Gemm { const bf16_t* A; const bf16_t* Bt; int K, lda, ldb, a_shift, a_gstride; const bf16_t* P; int ldp; };

struct StaticOrder {
    int nM, nN, nwg, G, c, wgm;
    __host__ __device__ __forceinline__ void init(int M, int N, int G_, int c_, int wgm_ = WGM) { nM = M / BM; nN = N / BM; nwg = nM * nN; G = G_; c = c_; wgm = wgm_; }
    __host__ __device__ __forceinline__ bool next(int i, Unit& u) const {
        const long L = (long)i * G + c; if (L >= nwg) return false;
        int wgid = (int)L; { const int q = nwg / NXCD, r = nwg % NXCD, xcd = wgid % NXCD, off = wgid / NXCD; wgid = (xcd < r ? xcd * (q + 1) : r * (q + 1) + (xcd - r) * q) + off; }
        const int nig = wgm * nN, gid = wgid / nig, fm = gid * wgm, gsz = (nM - fm) < wgm ? (nM - fm) : wgm;
        u.pm = fm + ((wgid % nig) % gsz); u.pn = (wgid % nig) / gsz; return true;
    }
};

template <class Epi, bool ALIGN_EPI = true, class Sched = StaticOrder, bool RESCALE = false, bool POOLF = false>
__device__ __forceinline__ void gemm_phase(LAS unsigned char* lds, const Gemm g, const Sched& S, const Epi& E, const int wave_s) {
    int tid = MK_TID(wave_s); asm volatile("" : "+v"(tid));
    const int wid = wave_s, lane = tid & 63, wr = wid >> 2, wc = wid & 3, fr = lane & 15, fq = lane >> 4;
    const int K = g.K, nt = K / BK;
    unsigned voffA[2], voffB[2], voffP[2];
#pragma unroll
    for (int i = 0; i < 2; ++i) { int R, C; stage_rc(tid * 16 + i * 8192, R, C); const int Rb = (R & ~31) + perm32(R & 31);
        voffA[i] = (unsigned)(R * g.lda + C) * 2u; voffB[i] = (unsigned)(Rb * g.ldb + C) * 2u; voffP[i] = POOLF ? (unsigned)(R * g.ldp + C) * 2u : 0u; }
    const size_t hstepP = POOLF ? (size_t)HALF * g.ldp * 2 : 0;
    const size_t kstep = (size_t)(BK * 2);
    const size_t hstepA = (size_t)HALF * g.lda * 2, hstepB = (size_t)HALF * g.ldb * 2;
    const unsigned ldsw = (unsigned)wid * 1024u;
    const int aoff = lds_byte(wr * 64 + fr, fq * 8), boff = lds_byte(wc * 32 + fr, fq * 8);
#define PG8_SA(b, h) (((b) * 2 + (h)) * HTB)
#define PG8_SB(b, h) ((4 + (b) * 2 + (h)) * HTB)
#define PG8_STAGE(bufoff, gbase, voff) do { _Pragma("unroll") for (int _i = 0; _i < 2; ++_i) \
        __builtin_amdgcn_global_load_lds((const unsigned*)((const char*)(gbase) + (voff)[_i]), (LAS unsigned*)(lds + (bufoff) + ldsw + _i * 8192), 16, 0, 0); } while (0)
#define PG8_LDA(dst, b, h) do { _Pragma("unroll") for (int m = 0; m < 4; ++m) _Pragma("unroll") for (int k = 0; k < 2; ++k) dst[m][k] = *(const LAS bf16x8*)(lds + PG8_SA(b, h) + aoff + m * 2048 + k * 1024); } while (0)
#define PG8_LDB(dst, b, h) do { _Pragma("unroll") for (int n = 0; n < 2; ++n) _Pragma("unroll") for (int k = 0; k < 2; ++k) dst[n][k] = *(const LAS bf16x8*)(lds + PG8_SB(b, h) + boff + n * 2048 + k * 1024); } while (0)
#define PG8_MMA(ai, bj, At, Bt) do { __builtin_amdgcn_s_setprio(1); _Pragma("unroll") for (int m = 0; m < 4; ++m) _Pragma("unroll") for (int n = 0; n < 2; ++n) _Pragma("unroll") for (int k = 0; k < 2; ++k) \
        acc[ai][bj][m][n] = __builtin_amdgcn_mfma_f32_16x16x32_bf16(Bt[n][k], At[m][k], acc[ai][bj][m][n], 0, 0, 0); __builtin_amdgcn_s_setprio(0); } while (0)
#define PG8_WAIT_V(n) asm volatile("s_waitcnt vmcnt(" #n ")" ::: "memory")
#define PG8_WAIT_L(n) asm volatile("s_waitcnt lgkmcnt(" #n ")" ::: "memory")
#define PG8_BAR __builtin_amdgcn_s_barrier()
#define PG8_SCHED __builtin_amdgcn_sched_barrier(0)
    Unit cur, nxt; int ui = 0;
    if (!S.next(0, cur)) return;
    f32x4 acc[2][2][4][2];
#pragma unroll
    for (int a = 0; a < 2; ++a)
#pragma unroll
        for (int b = 0; b < 2; ++b)
#pragma unroll
            for (int m = 0; m < 4; ++m)
#pragma unroll
                for (int n = 0; n < 2; ++n) acc[a][b][m][n] = (f32x4){0.f, 0.f, 0.f, 0.f};
    bf16x8 At[4][2], B0[2][2], B1[2][2];
    const char* cA = (const char*)g.A + (size_t)cur.pm * 2 * hstepA + (size_t)((cur.pn >> g.a_shift) * g.a_gstride) * 2;
    const char* cB = (const char*)g.Bt + (size_t)cur.pn * 2 * hstepB;
    const char* cP = POOLF ? (const char*)g.P + (size_t)cur.pm * 2 * hstepP + (size_t)((cur.pn >> 1) * 256) * 2 : cA;
    if constexpr (POOLF) {
    PG8_STAGE(PG8_SB(0, 0), cB, voffB); PG8_STAGE(PG8_SB(0, 1), cB + hstepB, voffB); PG8_STAGE(PG8_SA(0, 0), cP, voffP); PG8_STAGE(PG8_SA(0, 1), cP + hstepP, voffP);
    if (wr == 1) PG8_BAR;
    PG8_WAIT_V(2); PG8_BAR;
    PG8_STAGE(PG8_SB(1, 0), cB + kstep, voffB); PG8_STAGE(PG8_SA(1, 0), cP + kstep, voffP); PG8_STAGE(PG8_SB(1, 1), cB + hstepB + kstep, voffB);
    PG8_WAIT_V(6); PG8_BAR;
    } else {
    PG8_STAGE(PG8_SB(0, 0), cB, voffB); PG8_STAGE(PG8_SB(0, 1), cB + hstepB, voffB); PG8_STAGE(PG8_SA(0, 0), cA, voffA); PG8_STAGE(PG8_SA(0, 1), cA + hstepA, voffA);
    if (wr == 1) PG8_BAR;
    PG8_WAIT_V(2); PG8_BAR;
    PG8_STAGE(PG8_SB(1, 0), cB + kstep, voffB); PG8_STAGE(PG8_SA(1, 0), cA + kstep, voffA); PG8_STAGE(PG8_SB(1, 1), cB + hstepB + kstep, voffB);
    PG8_WAIT_V(6); PG8_BAR;
    }
    for (;;) {
        const bool has_next = S.next(ui + 1, nxt);
        const char* nA = has_next ? (const char*)g.A + (size_t)nxt.pm * 2 * hstepA + (size_t)((nxt.pn >> g.a_shift) * g.a_gstride) * 2 : cA;
        const char* nB = has_next ? (const char*)g.Bt + (size_t)nxt.pn * 2 * hstepB : cB;
        const char* nP = (POOLF && has_next) ? (const char*)g.P + (size_t)nxt.pm * 2 * hstepP + (size_t)((nxt.pn >> 1) * 256) * 2 : cP;
        for (int t = 0; t < nt; t += 2) {
            const bool last = (t == nt - 2);
            const char* a1; const char* a2; bool k1 = false, k2 = false;
            if constexpr (POOLF) {
                k1 = (t + 1 < 4); k2 = (t + 2 < 4) || last;
                a1 = k1 ? cP + (size_t)(t + 1) * kstep : cA + (size_t)(t + 1 - 4) * kstep;
                a2 = last ? nP : (k2 ? cP + (size_t)(t + 2) * kstep : cA + (size_t)(t + 2 - 4) * kstep);
            } else { a1 = cA + (size_t)(t + 1) * kstep; a2 = last ? nA : cA + (size_t)(t + 2) * kstep; }
            const char* b2 = last ? nB : cB + (size_t)(t + 2) * kstep;
            const char* a3 = a2 + kstep; const char* b3 = b2 + kstep;
            const unsigned v1[2] = {k1 ? voffP[0] : voffA[0], k1 ? voffP[1] : voffA[1]}, v2[2] = {k2 ? voffP[0] : voffA[0], k2 ? voffP[1] : voffA[1]};
            const size_t h1 = k1 ? hstepP : hstepA, h2 = k2 ? hstepP : hstepA;
            if constexpr (POOLF) { if (t == 4) { int frl = fr; asm volatile("" : "+v"(frl)); __builtin_amdgcn_s_setprio(1); E.mid(acc, cur, wr, wc, frl, fq); __builtin_amdgcn_s_setprio(0); } }
            if constexpr (RESCALE) {
                constexpr int T0 = POOLF ? 4 : 0;
                if (t > T0 && ((t - T0) & 7) == 0) { __builtin_amdgcn_s_setprio(1); const LAS float* rt = (const LAS float*)(lds + STAGE_BYTES) + (((t - T0) >> 3) - 1);
#pragma unroll
                    for (int a = 0; a < 2; ++a)
#pragma unroll
                        for (int m = 0; m < 4; ++m) { const float f = rt[(a * 128 + wr * 64 + m * 16 + fr) * 4];
#pragma unroll
                            for (int b = 0; b < 2; ++b) { acc[a][b][m][0] *= f; acc[a][b][m][1] *= f; } } __builtin_amdgcn_s_setprio(0); }
            }
            PG8_LDB(B0, 0, 0); PG8_LDB(B1, 0, 1); PG8_SCHED; PG8_LDA(At, 0, 0); PG8_STAGE(PG8_SA(1, 1), a1 + h1, v1);
            PG8_WAIT_V(8); PG8_WAIT_L(0); PG8_BAR; PG8_MMA(0, 0, At, B0); PG8_MMA(0, 1, At, B1); PG8_BAR; PG8_SCHED;
            PG8_LDA(At, 0, 1); PG8_STAGE(PG8_SB(0, 0), b2, voffB); PG8_STAGE(PG8_SB(0, 1), b2 + hstepB, voffB); PG8_STAGE(PG8_SA(0, 0), a2, v2);
            PG8_WAIT_V(8); PG8_WAIT_L(0); PG8_BAR; PG8_MMA(1, 0, At, B0); PG8_MMA(1, 1, At, B1); PG8_BAR; PG8_SCHED;
            PG8_LDB(B0, 1, 0); PG8_LDB(B1, 1, 1); PG8_SCHED; PG8_LDA(At, 1, 0); PG8_STAGE(PG8_SA(0, 1), a2 + h2, v2);
            PG8_WAIT_V(8); PG8_WAIT_L(0); PG8_BAR; PG8_MMA(0, 0, At, B0); PG8_MMA(0, 1, At, B1); PG8_BAR; PG8_SCHED;
            PG8_LDA(At, 1, 1); PG8_STAGE(PG8_SB(1, 0), b3, voffB); PG8_STAGE(PG8_SB(1, 1), b3 + hstepB, voffB); PG8_STAGE(PG8_SA(1, 0), a3, v2);
            PG8_WAIT_V(8); PG8_WAIT_L(0); PG8_BAR; PG8_MMA(1, 0, At, B0); PG8_MMA(1, 1, At, B1); PG8_BAR; PG8_SCHED;
        }
        if constexpr (ALIGN_EPI) { if (wr == 0) PG8_BAR; }
        E(acc, cur, wr, wc, fr, fq);
        if (!has_next) break;
#pragma unroll
        for (int a = 0; a < 2; ++a)
#pragma unroll
            for (int b = 0; b < 2; ++b)
#pragma unroll
                for (int m = 0; m < 4; ++m)
#pragma unroll
                    for (int n = 0; n < 2; ++n) acc[a][b][m][n] = (f32x4){0.f, 0.f, 0.f, 0.f};
        cur = nxt; cA = nA; cB = nB; cP = nP; ++ui;
        if constexpr (ALIGN_EPI) { if (wr == 1) PG8_BAR; }
    }
    PG8_WAIT_V(0);
    if constexpr (!ALIGN_EPI) { if (wr == 0) PG8_BAR; }
    PG8_BAR;
#undef PG8_SA
#undef PG8_SB
#undef PG8_STAGE
#undef PG8_LDA
#undef PG8_LDB
#undef PG8_MMA
#undef PG8_WAIT_V
#undef PG8_WAIT_L
#undef PG8_BAR
#undef PG8_SCHED
}
}


#define XB_TMO      128
#define XB_XCNT(j)  (256  + 64 * (j))
#define XB_XSUB(j)  (1280 + 64 * (j))
#define XB_XGEN(j)  (2304 + 64 * (j))
#define XB_TOP      3328
#define XB_TOPGEN   3392
#define XCD_BAR_WORDS 3456
#define XB_SPIN_CAP (1u << 18)
__device__ __forceinline__ unsigned xb_ld(unsigned* p)              { return __hip_atomic_load(p, __ATOMIC_RELAXED, __HIP_MEMORY_SCOPE_AGENT); }
__device__ __forceinline__ unsigned xb_add(unsigned* p, unsigned v) { return __hip_atomic_fetch_add(p, v, __ATOMIC_RELAXED, __HIP_MEMORY_SCOPE_AGENT); }
__device__ __forceinline__ unsigned xb_xcc_id() { return (unsigned)__builtin_amdgcn_s_getreg((3 << 11) | 20) & 0xFu; }
#define XB_SPIN(cond, bar) do { unsigned _sp = 0; while (cond) { __builtin_amdgcn_s_sleep(1); \
    if ((++_sp & 255u) == 0u) { if (xb_ld(&(bar)[XB_TMO])) break; if (_sp > XB_SPIN_CAP) { atomicAdd(&(bar)[XB_TMO], 1u); break; } } } } while (0)
struct XcdBarrier { unsigned* bar; unsigned x; volatile LAS unsigned* st; };
__device__ __forceinline__ XcdBarrier xcd_barrier_post(unsigned* bar, volatile LAS unsigned* st, const bool t0) {
    XcdBarrier b; b.bar = bar; b.x = xb_xcc_id(); b.st = st;
    if (t0) st[3] = xb_add(&bar[XB_XCNT(b.x)], 1u);
    return b;
}
__device__ __forceinline__ void xcd_barrier_complete(unsigned* bar, unsigned x, unsigned& nloc, unsigned& nx, unsigned& even) {
    const unsigned G = gridDim.x * gridDim.y * gridDim.z;
    unsigned sum, cnt, mine, ok8, sp = 0u;
    for (;;) {
        sum = 0u; cnt = 0u; mine = 0u; ok8 = 0u;
#pragma unroll
        for (unsigned j = 0; j < 16; ++j) { const unsigned c = xb_ld(&bar[XB_XCNT(j)]); sum += c; cnt += (c > 0u) ? 1u : 0u; mine = (j == x) ? c : mine; ok8 += (j < 8u && c * 8u == G) ? 1u : 0u; }
        if (sum == G) break;
        __builtin_amdgcn_s_sleep(1);
        if ((++sp & 255u) == 0u) { if (xb_ld(&bar[XB_TMO])) break; if (sp > XB_SPIN_CAP) { atomicAdd(&bar[XB_TMO], 1u); break; } }
    }
    nloc = mine > 0u ? mine : 1u; nx = cnt > 0u ? cnt : 1u; even = (sum == G && ok8 == 8u) ? 1u : 0u;
}
__device__ __forceinline__ void xcd_barrier(const XcdBarrier& b, const bool t0, const bool local) {
    asm volatile("s_waitcnt vmcnt(0)" ::: "memory");
    __syncthreads();
    if (t0) {
        unsigned* bar = b.bar;
        __builtin_amdgcn_s_waitcnt(0);
        unsigned nloc = b.st[0], nx = b.st[1];
        if (nloc == 0u) { unsigned even; xcd_barrier_complete(bar, b.x, nloc, nx, even); b.st[0] = nloc; b.st[1] = nx; b.st[2] = even; }
        const unsigned old = xb_add(&bar[XB_XSUB(b.x)], 1u);
        const unsigned gen = old / nloc;
        if (old + 1u == (gen + 1u) * nloc) {
            if (!local) {
            __builtin_amdgcn_fence(__ATOMIC_RELEASE, "agent");
            asm volatile("s_waitcnt vmcnt(0)" ::: "memory");
            const unsigned og = xb_add(&bar[XB_TOP], 1u);
            const unsigned tg = og / nx;
            if (og + 1u == (tg + 1u) * nx) xb_add(&bar[XB_TOPGEN], 1u);
            else XB_SPIN(xb_ld(&bar[XB_TOPGEN]) == tg, bar);
            }
            __builtin_amdgcn_fence(__ATOMIC_ACQUIRE, "agent");
            xb_add(&bar[XB_XGEN(b.x)], 1u);
            asm volatile("s_waitcnt vmcnt(0)" ::: "memory");
        } else {
            XB_SPIN(xb_ld(&bar[XB_XGEN(b.x)]) == gen, bar);
            __builtin_amdgcn_fence(__ATOMIC_ACQUIRE, "agent");
            asm volatile("s_waitcnt vmcnt(0)" ::: "memory");
        }
    }
    __syncthreads();
}

constexpr int DM = 2048, SEQ = 2048, NB = 8, M = NB * SEQ, INW = 11280, FF = 8192, NPROJ_T = 44;
constexpr float EPS = 1e-6f;
constexpr size_t MiB = 1u << 20;
constexpr size_t WS_RSS1 = 0, WS_RSS2 = 64 * 1024, WS_BAR = 128 * 1024, WS_ZERO_BYTES = 160 * 1024;
constexpr size_t WS_WIN = 1 * MiB, WS_WOUT = 46 * MiB, WS_H = 54 * MiB, WS_WUP = 54 * MiB, WS_WDN = 86 * MiB;
constexpr size_t WS_U = 118 * MiB, WS_KDT = 150 * MiB, WS_Q = 182 * MiB, WS_K = 214 * MiB, WS_V = 246 * MiB, WS_G = 310 * MiB, WS_GATES = 374 * MiB, WS_END = 502 * MiB;
constexpr size_t WS_X1N = 118 * MiB, WS_MIXED = 182 * MiB, WS_UPACT = 246 * MiB;
constexpr size_t DO_ON = 0, DO_D = 64 * MiB, DO_WG = 96 * MiB  , DO_SS = 105 * MiB, DO_ALOW = 107 * MiB, DO_DEC = 108 * MiB;

constexpr int LDS_BYTES = 147456;
constexpr int NTHREADS = 512;

struct EpiProj {
    unsigned char* ws;
    __device__ __forceinline__ void operator()(const f32x4 (&acc)[2][2][4][2], const pg8::Unit& u, int wr, int wc, int fr, int fq) const {
        const int pn = u.pn; const int row0 = u.pm * 256 + wr * 64 + fr;
        bf16_t* base; int ld, ct; float sc = 1.f; bool sig = false;
        if (pn < 4) { base = (bf16_t*)(ws + WS_U); ld = 1024; ct = pn; }
        else if (pn < 8) { base = (bf16_t*)(ws + WS_Q); ld = 1024; ct = pn - 4; sc = 0.0625f; }
        else if (pn < 12) { base = (bf16_t*)(ws + WS_K); ld = 1024; ct = pn - 8; }
        else if (pn < 20) { base = (bf16_t*)(ws + WS_V); ld = 2048; ct = pn - 12; }
        else if (pn < 28) { base = (bf16_t*)(ws + WS_G); ld = 2048; ct = pn - 20; }
        else { base = (bf16_t*)(ws + WS_GATES); ld = 4096; ct = pn - 28; sig = true; }
        const int col0 = ct * 256 + wc * 32 + 8 * fq;
#pragma unroll
        for (int ai = 0; ai < 2; ++ai)
#pragma unroll
            for (int m = 0; m < 4; ++m) { bf16_t* rowp = base + (size_t)(row0 + ai * 128 + m * 16) * ld + col0;
#pragma unroll
                for (int bj = 0; bj < 2; ++bj) { f32x4 v0 = acc[ai][bj][m][0] * sc, v1 = acc[ai][bj][m][1] * sc;
                    if (sig) {
#pragma unroll
                        for (int j = 0; j < 4; ++j) { v0[j] = fast_sigmoid(v0[j]); v1[j] = fast_sigmoid(v1[j]); } }
                    u32x4 w; w.x = cvt_pk_bf16(v0[0], v0[1]); w.y = cvt_pk_bf16(v0[2], v0[3]); w.z = cvt_pk_bf16(v1[0], v1[1]); w.w = cvt_pk_bf16(v1[2], v1[3]);
                    *(u32x4*)(rowp + bj * 128) = w; } }
    }
};
struct EpiMixF {
    const bf16_t* gates; bf16_t* mixed; const LAS float* rt;
    __device__ __forceinline__ void mid(f32x4 (&acc)[2][2][4][2], const pg8::Unit& u, int wr, int wc, int fr, int fq) const {
        const int row0 = u.pm * 256 + wr * 64 + fr, col0 = u.pn * 256 + wc * 32 + 8 * fq;
#pragma unroll
        for (int ai = 0; ai < 2; ++ai)
#pragma unroll
            for (int m = 0; m < 4; ++m) { const size_t r = (size_t)(row0 + ai * 128 + m * 16);
                const f32x4 t4 = *(const LAS f32x4*)(rt + (ai * 128 + wr * 64 + m * 16 + fr) * 4); const float ir0 = __builtin_amdgcn_rcpf(t4.x * t4.y * t4.z * t4.w);
#pragma unroll
                for (int bj = 0; bj < 2; ++bj) { const u32x4 pw = *(const u32x4*)(gates + r * 4096 + col0 + bj * 128), gw = *(const u32x4*)(gates + r * 4096 + 2048 + col0 + bj * 128);
                    f32x4 f0, f1;
                    f0[0] = bflo(pw.x) * ir0 * __builtin_amdgcn_rcpf(fmaxf(bflo(gw.x), 1e-20f)); f0[1] = bfhi(pw.x) * ir0 * __builtin_amdgcn_rcpf(fmaxf(bfhi(gw.x), 1e-20f));
                    f0[2] = bflo(pw.y) * ir0 * __builtin_amdgcn_rcpf(fmaxf(bflo(gw.y), 1e-20f)); f0[3] = bfhi(pw.y) * ir0 * __builtin_amdgcn_rcpf(fmaxf(bfhi(gw.y), 1e-20f));
                    f1[0] = bflo(pw.z) * ir0 * __builtin_amdgcn_rcpf(fmaxf(bflo(gw.z), 1e-20f)); f1[1] = bfhi(pw.z) * ir0 * __builtin_amdgcn_rcpf(fmaxf(bfhi(gw.z), 1e-20f));
                    f1[2] = bflo(pw.w) * ir0 * __builtin_amdgcn_rcpf(fmaxf(bflo(gw.w), 1e-20f)); f1[3] = bfhi(pw.w) * ir0 * __builtin_amdgcn_rcpf(fmaxf(bfhi(gw.w), 1e-20f));
                    acc[ai][bj][m][0] *= f0; acc[ai][bj][m][1] *= f1; } }
    }
    __device__ __forceinline__ void operator()(const f32x4 (&acc)[2][2][4][2], const pg8::Unit& u, int wr, int wc, int fr, int fq) const {
        const int row0 = u.pm * 256 + wr * 64 + fr, col0 = u.pn * 256 + wc * 32 + 8 * fq;
#pragma unroll
        for (int ai = 0; ai < 2; ++ai)
#pragma unroll
            for (int m = 0; m < 4; ++m) { const size_t r = (size_t)(row0 + ai * 128 + m * 16);
                const float r3 = rt[(ai * 128 + wr * 64 + m * 16 + fr) * 4 + 3];
#pragma unroll
                for (int bj = 0; bj < 2; ++bj) { const u32x4 gw = *(const u32x4*)(gates + r * 4096 + 2048 + col0 + bj * 128);
                    const f32x4 v0 = acc[ai][bj][m][0] * r3, v1 = acc[ai][bj][m][1] * r3;
                    u32x4 w; w.x = cvt_pk_bf16(v0[0] * fmaxf(bflo(gw.x), 1e-20f), v0[1] * fmaxf(bfhi(gw.x), 1e-20f)); w.y = cvt_pk_bf16(v0[2] * fmaxf(bflo(gw.y), 1e-20f), v0[3] * fmaxf(bfhi(gw.y), 1e-20f));
                    w.z = cvt_pk_bf16(v1[0] * fmaxf(bflo(gw.z), 1e-20f), v1[1] * fmaxf(bfhi(gw.z), 1e-20f)); w.w = cvt_pk_bf16(v1[2] * fmaxf(bflo(gw.w), 1e-20f), v1[3] * fmaxf(bfhi(gw.w), 1e-20f));
                    *(u32x4*)(mixed + r * 2048 + col0 + bj * 128) = w; } }
    }
};
template <bool FIRST> struct EpiRes {
    const float* xin; bf16_t* xs; float* rss;
    __device__ __forceinline__ void operator()(const f32x4 (&acc)[2][2][4][2], const pg8::Unit& u, int wr, int wc, int fr, int fq) const {
        const int row0 = u.pm * 256 + wr * 64 + fr, col0 = u.pn * 256 + wc * 32 + 8 * fq;
#pragma unroll
        for (int ai = 0; ai < 2; ++ai)
#pragma unroll
            for (int m = 0; m < 4; ++m) { const size_t r = (size_t)(row0 + ai * 128 + m * 16); float ss = 0.f;
#pragma unroll
                for (int bj = 0; bj < 2; ++bj) { const size_t off = r * 2048 + col0 + bj * 128;
                    f32x4 x0, x1;
                    if (FIRST) { x0 = *(const f32x4*)(xin + off); x1 = *(const f32x4*)(xin + off + 4); }
                    else { const u32x4 xw = *(const u32x4*)(xs + off); x0 = (f32x4){bflo(xw.x), bfhi(xw.x), bflo(xw.y), bfhi(xw.y)}; x1 = (f32x4){bflo(xw.z), bfhi(xw.z), bflo(xw.w), bfhi(xw.w)}; }
                    const f32x4 v0 = x0 + acc[ai][bj][m][0], v1 = x1 + acc[ai][bj][m][1];
                    u32x4 w; w.x = cvt_pk_bf16(v0[0], v0[1]); w.y = cvt_pk_bf16(v0[2], v0[3]); w.z = cvt_pk_bf16(v1[0], v1[1]); w.w = cvt_pk_bf16(v1[2], v1[3]); *(u32x4*)(xs + off) = w;
                    if (FIRST) ss += (v0[0] * v0[0] + v0[1] * v0[1]) + (v0[2] * v0[2] + v0[3] * v0[3]) + (v1[0] * v1[0] + v1[1] * v1[1]) + (v1[2] * v1[2] + v1[3] * v1[3]); }
                if (FIRST) { ss += __shfl_xor(ss, 16); ss += __shfl_xor(ss, 32);
                    if (fq == 0) unsafeAtomicAdd(rss + r, ss); } }
    }
};
struct EpiUp {
    const float* rss; bf16_t* up;
    __device__ __forceinline__ void operator()(const f32x4 (&acc)[2][2][4][2], const pg8::Unit& u, int wr, int wc, int fr, int fq) const {
        const int row0 = u.pm * 256 + wr * 64 + fr, col0 = u.pn * 256 + wc * 32 + 8 * fq;
#pragma unroll
        for (int ai = 0; ai < 2; ++ai)
#pragma unroll
            for (int m = 0; m < 4; ++m) { const size_t r = (size_t)(row0 + ai * 128 + m * 16);
                const float rs = rsqrtf(rss[r] * (1.0f / DM) + EPS);
#pragma unroll
                for (int bj = 0; bj < 2; ++bj) { f32x4 v0 = acc[ai][bj][m][0] * rs, v1 = acc[ai][bj][m][1] * rs;
#pragma unroll
                    for (int j = 0; j < 4; ++j) { v0[j] = fmaxf(v0[j], 0.f); v0[j] *= v0[j]; v1[j] = fmaxf(v1[j], 0.f); v1[j] *= v1[j]; }
                    u32x4 w; w.x = cvt_pk_bf16(v0[0], v0[1]); w.y = cvt_pk_bf16(v0[2], v0[3]); w.z = cvt_pk_bf16(v1[0], v1[1]); w.w = cvt_pk_bf16(v1[2], v1[3]);
                    *(u32x4*)(up + r * FF + col0 + bj * 128) = w; } }
    }
};


#if PROBE_K
struct EpiNull { float* sink;
    __device__ __forceinline__ void operator()(const f32x4 (&acc)[2][2][4][2], const pg8::Unit& u, int wr, int wc, int fr, int fq) const {
        f32x4 t = (f32x4){0.f, 0.f, 0.f, 0.f};
#pragma unroll
        for (int ai = 0; ai < 2; ++ai)
#pragma unroll
            for (int bj = 0; bj < 2; ++bj)
#pragma unroll
                for (int m = 0; m < 4; ++m) { t += acc[ai][bj][m][0]; t += acc[ai][bj][m][1]; }
        if (t[0] + t[1] + t[2] + t[3] == 123456.789f) sink[0] = t[0];
    }
};
struct FixedOrder : pg8::StaticOrder {
    __device__ bool next(int i, pg8::Unit& u) const { const bool r = pg8::StaticOrder::next(i, u); u.pm = 0; u.pn = 0; return r; }
};
#endif

__device__ __forceinline__ float wave_sum(float v) {
#pragma unroll
    for (int o = 1; o < 64; o <<= 1) v += __shfl_xor(v, o);
    return v;
}
template <bool NTS = false> __device__ __forceinline__ void transpose_item(const float* __restrict__ W, int ldw, int col0, int nvalid, const float* __restrict__ kscale, const float* __restrict__ nscale,
                                               bf16_t* __restrict__ WT, int ldt, int row0, int k0, LAS float* scr, int lane) {
    const int nl = lane & 31;
    float tv[32];
#pragma unroll
    for (int i = 0; i < 32; ++i) { const int kk = 2 * i + (lane >> 5); tv[i] = (nl < nvalid) ? __builtin_nontemporal_load(W + (size_t)(k0 + kk) * ldw + col0 + nl) : 0.f; }
    if (kscale) {
#pragma unroll
        for (int i = 0; i < 32; ++i) tv[i] *= kscale[k0 + 2 * i + (lane >> 5)]; }
#pragma unroll
    for (int i = 0; i < 32; ++i) scr[(2 * i + (lane >> 5)) * 33 + nl] = tv[i];
    LDS_WAIT();
    const int c = lane & 7;
#pragma unroll
    for (int j = 0; j < 4; ++j) { const int n = (lane >> 3) + 8 * j; const LAS float* s = scr + (8 * c) * 33 + n;
        const float ns = nscale ? nscale[row0 + n] : 1.0f;
        u32x4 o; o.x = cvt_pk_bf16(s[0 * 33] * ns, s[1 * 33] * ns); o.y = cvt_pk_bf16(s[2 * 33] * ns, s[3 * 33] * ns); o.z = cvt_pk_bf16(s[4 * 33] * ns, s[5 * 33] * ns); o.w = cvt_pk_bf16(s[6 * 33] * ns, s[7 * 33] * ns);
        if (NTS) __builtin_nontemporal_store(o, (u32x4*)(WT + (size_t)(row0 + n) * ldt + k0 + 8 * c)); else *(u32x4*)(WT + (size_t)(row0 + n) * ldt + k0 + 8 * c) = o; }
    LDS_WAIT();
}


template <int W> __device__ __forceinline__ void pool_task(const bf16_t* __restrict__ up, bf16_t* __restrict__ dp, int tp) {
    u32x4 r[W - 1 + 16];
#pragma unroll
    for (int j = 0; j < W - 1; ++j) r[j] = (tp - (W - 1) + j >= 0) ? *(const u32x4*)(up + (ptrdiff_t)(j - (W - 1)) * 1024) : (u32x4){0u, 0u, 0u, 0u};
#pragma unroll
    for (int i = 0; i < 16; ++i) r[W - 1 + i] = *(const u32x4*)(up + (size_t)i * 1024);
    float s[8];
#pragma unroll
    for (int e = 0; e < 8; ++e) s[e] = 0.f;
#pragma unroll
    for (int j = 0; j < W - 1; ++j) { s[0] += bflo(r[j].x); s[1] += bfhi(r[j].x); s[2] += bflo(r[j].y); s[3] += bfhi(r[j].y); s[4] += bflo(r[j].z); s[5] += bfhi(r[j].z); s[6] += bflo(r[j].w); s[7] += bfhi(r[j].w); }
#pragma unroll
    for (int i = 0; i < 16; ++i) {
        const u32x4 uu = r[W - 1 + i];
        const float uf[8] = {bflo(uu.x), bfhi(uu.x), bflo(uu.y), bfhi(uu.y), bflo(uu.z), bfhi(uu.z), bflo(uu.w), bfhi(uu.w)};
        const int cnt = (tp + i + 1) < W ? (tp + i + 1) : W; const float inv = 1.0f / (float)cnt;
        float d[8];
#pragma unroll
        for (int e = 0; e < 8; ++e) { s[e] += uf[e]; d[e] = s[e] * inv - uf[e]; }
        u32x4 o; o.x = cvt_pk_bf16(d[0], d[1]); o.y = cvt_pk_bf16(d[2], d[3]); o.z = cvt_pk_bf16(d[4], d[5]); o.w = cvt_pk_bf16(d[6], d[7]);
        *(u32x4*)(dp + (size_t)i * 1024) = o;
        const u32x4 ub = r[i];
        s[0] -= bflo(ub.x); s[1] -= bfhi(ub.x); s[2] -= bflo(ub.y); s[3] -= bfhi(ub.y); s[4] -= bflo(ub.z); s[5] -= bfhi(ub.z); s[6] -= bflo(ub.w); s[7] -= bfhi(ub.w);
    }
}

struct Args { const float* in[14]; float* out; unsigned char* ws; int ph_lo, ph_hi; };
constexpr int N_PHASES = 10;

__global__ void __launch_bounds__(NTHREADS, 2) mk_fwd(Args args) {
    extern __shared__ __attribute__((aligned(16))) unsigned char lds_raw[];
    LAS unsigned char* lds = (LAS unsigned char*)lds_raw;
    const int wave_s = __builtin_amdgcn_readfirstlane((int)threadIdx.x >> 6);
#define PHASE_IDS() int tid = MK_TID(wave_s); asm volatile("" : "+v"(tid)); const int lane = tid & 63, wave = wave_s; (void)lane; (void)wave
    const int G = gridDim.x, bx = blockIdx.x;
    const int vcu = (G % 8 == 0) ? (bx % 8) * (G / 8) + bx / 8 : bx;
    unsigned char* ws = args.ws; unsigned char* dob = (unsigned char*)args.out;
    const float* x = args.in[0];
    const int lo = args.ph_lo, hi = args.ph_hi;
#define IN(k) (lo <= (k) && (k) < hi)
    volatile LAS unsigned* bst = (volatile LAS unsigned*)(lds + LDS_BYTES - 16);
    if (MK_TID(wave_s) < 4) bst[MK_TID(wave_s)] = 0u;
    __syncthreads();
    XcdBarrier gbar; gbar.bar = (unsigned*)(ws + WS_BAR); gbar.x = 0; gbar.st = bst;
    if (hi - lo > 1) gbar = xcd_barrier_post((unsigned*)(ws + WS_BAR), bst, MK_TID(wave_s) == 0);
    if (lo < 0) cg::this_grid().sync();
#define SEAM(k) do { if (IN(k) && IN((k) + 1)) { xcd_barrier(gbar, MK_TID(wave_s) == 0, (k) > 0 && xloc != 0); } } while (0)
    int xloc = 0, vcu2 = vcu, cid = bx;
#define REPS(k) (((PROBE_REP >> (k)) & 1) ? 2 : 1)

    bf16_t* const WIN_T = (bf16_t*)(ws + WS_WIN); bf16_t* const WOUT_T = (bf16_t*)(ws + WS_WOUT); bf16_t* const WUP_T = (bf16_t*)(ws + WS_WUP); bf16_t* const WDN_T = (bf16_t*)(ws + WS_WDN);
    bf16_t* const HB = (bf16_t*)((unsigned char*)args.out + DO_ON);     bf16_t* const UB = (bf16_t*)(ws + WS_U); bf16_t* const KDT = (bf16_t*)(ws + WS_KDT);
    bf16_t* const QB = (bf16_t*)(ws + WS_Q); bf16_t* const KB = (bf16_t*)(ws + WS_K); bf16_t* const VB = (bf16_t*)(ws + WS_V); bf16_t* const GB = (bf16_t*)(ws + WS_G);
    bf16_t* const GATES = (bf16_t*)(ws + WS_GATES); bf16_t* const X1N = (bf16_t*)(ws + WS_X1N); bf16_t* const MIXED = (bf16_t*)(ws + WS_MIXED); bf16_t* const UPACT = (bf16_t*)(ws + WS_UPACT);
    float* const RSS1 = (float*)(ws + WS_RSS1); float* const RSS2 = (float*)(ws + WS_RSS2);
    bf16_t* const ONB = (bf16_t*)(dob + DO_ON); bf16_t* const DB = (bf16_t*)(dob + DO_D); bf16_t* const WG_T = (bf16_t*)(dob + DO_WG);
    float* const SSP = (float*)(dob + DO_SS); float* const DEC = (float*)(dob + DO_DEC);

    if (IN(0)) for (int rep = 0; rep < REPS(0); ++rep) {
        PHASE_IDS();
        LAS float* scr = (LAS float*)(lds + wave * 16384);
        const int gw = vcu * 8 + wave, NGW = G * 8;
        constexpr int I_WIN = 353 * 32, I_POOL = 256, I_WG = 32 * 64, I_WO = 32 * 64, NIT = I_WIN + I_POOL + I_WG + I_WO;
        for (int it = gw; it < NIT; it += NGW) {
            int r = it;
            if (r < I_WIN) { const int nb = r % 353, kb = r / 353; int col0, row0, nv = 32;
                if (nb < 224) { col0 = 32 * nb; row0 = 32 * nb; } else if (nb < 352) { col0 = 7184 + 32 * (nb - 224); row0 = 7168 + 32 * (nb - 224); } else { col0 = 7168; row0 = 11264; nv = 16; }
                transpose_item(args.in[2], INW, col0, nv, nullptr, nullptr, WIN_T, DM, row0, kb * 64, scr, lane); continue; }
            r -= I_WIN;
            if (r < I_POOL) { const int gi = r >> 6, q = r & 63, kb = q >> 4, nb = q & 15;
                transpose_item(args.in[3] + (size_t)gi * 256 * 512, 512, 32 * nb, 32, nullptr, args.in[4], WG_T, 2304, gi * 512 + 32 * nb, kb * 64, scr, lane); continue; }
            r -= I_POOL;
            if (r < I_WG) { const int nb = r & 63, kb = r >> 6; transpose_item<true>(args.in[8], DM, 32 * nb, 32, nullptr, nullptr, WG_T + 256, 2304, 32 * nb, kb * 64, scr, lane); continue; }
            r -= I_WG;
            { const int nb = r & 63, kb = r >> 6; transpose_item<true>(args.in[9], DM, 32 * nb, 32, nullptr, nullptr, WOUT_T, DM, 32 * nb, kb * 64, scr, lane); }
        }
        {
            constexpr int I_UP = 32 * 256, I_DN = 128 * 64;
            for (int it = gw; it < I_UP + I_DN; it += NGW) {
                if (it < I_UP) { const int nb = it & 255, kb = it >> 8; transpose_item<true>(args.in[11], FF, 32 * nb, 32, args.in[10], nullptr, WUP_T, DM, 32 * nb, kb * 64, scr, lane); }
                else { const int r = it - I_UP, nb = r & 63, kb = r >> 6; transpose_item<true>(args.in[12], DM, 32 * nb, 32, nullptr, nullptr, WDN_T, FF, 32 * nb, kb * 64, scr, lane); }
            }
        }
        const float* g1 = args.in[1];
        for (int m = gw; m < M; m += NGW) {
            const f32x4* xr = (const f32x4*)(x + (size_t)m * DM) + lane; f32x4 v[8]; float s = 0.f;
#pragma unroll
            for (int j = 0; j < 8; ++j) { v[j] = __builtin_nontemporal_load(xr + 64 * j); s += (v[j].x * v[j].x + v[j].y * v[j].y) + (v[j].z * v[j].z + v[j].w * v[j].w); }
            const float rstd = rsqrtf(wave_sum(s) * (1.0f / DM) + EPS);
            u32x2* o8 = (u32x2*)(HB + (size_t)m * DM) + lane;
#pragma unroll
            for (int j = 0; j < 8; ++j) { const f32x4 gg = ((const f32x4*)g1)[64 * j + lane]; u32x2 w; w.x = cvt_pk_bf16(v[j].x * rstd * gg.x, v[j].y * rstd * gg.y); w.y = cvt_pk_bf16(v[j].z * rstd * gg.z, v[j].w * rstd * gg.w); o8[64 * j] = w; }
        }
    }
    SEAM(0);
    if (IN(0) && IN(1)) {
        const unsigned ev = __builtin_amdgcn_readfirstlane(bst[2]), tk = __builtin_amdgcn_readfirstlane(bst[3]);
        if (ev != 0u && G == 256 && tk < 32u) { xloc = 1; vcu2 = (int)gbar.x * 32 + (int)tk; cid = (int)tk * 8 + (int)gbar.x; }
    }

    if (IN(1)) for (int rep = 0; rep < REPS(1); ++rep) {
        pg8::Gemm g{HB, WIN_T, DM, DM, DM, 0, 0}; pg8::StaticOrder S; S.init(M, NPROJ_T * 256, G, cid);
        EpiProj E{ws};
        pg8::gemm_phase<EpiProj>(lds, g, S, E, wave_s);
    }
    SEAM(1);

    if (IN(2)) for (int rep = 0; rep < REPS(2); ++rep) {
        {
            PHASE_IDS();
            LAS float* al = (LAS float*)lds; const LAS f32x4* al4 = (const LAS f32x4*)lds;
            LAS float* red = (LAS float*)(lds + 4096);
            LAS unsigned char* kimg = lds + 4096;
            const float* w_alpha = args.in[5]; const float* b_alpha = args.in[6];
            const int l16 = lane & 15, g4 = lane >> 4;
            for (int item = vcu2; item < M / 64; item += G) {
                __syncthreads();
                {   f32x4 pa[4];
#pragma unroll
                    for (int mt = 0; mt < 4; ++mt) pa[mt] = (f32x4){0.f, 0.f, 0.f, 0.f};
                    const bf16_t* hp = HB + (size_t)(item * 64 + l16) * DM + 256 * wave + 8 * g4;
                    const bf16_t* wp = WIN_T + (size_t)(11264 + l16) * DM + 256 * wave + 8 * g4;
#pragma unroll
                    for (int ks = 0; ks < 8; ++ks) {
                        const bf16x8 bfr = *(const bf16x8*)(wp + 32 * ks);
#pragma unroll
                        for (int mt = 0; mt < 4; ++mt) { const bf16x8 afr = *(const bf16x8*)(hp + (size_t)(16 * mt) * DM + 32 * ks);
                            pa[mt] = __builtin_amdgcn_mfma_f32_16x16x32_bf16(afr, bfr, pa[mt], 0, 0, 0); }
                    }
#pragma unroll
                    for (int mt = 0; mt < 4; ++mt)
#pragma unroll
                        for (int i = 0; i < 4; ++i) red[wave * 1024 + (16 * mt + 4 * g4 + i) * 16 + l16] = pa[mt][i];
                }
                __syncthreads();
                { float a0 = 0.f, a1 = 0.f;
#pragma unroll
                  for (int w8 = 0; w8 < 8; ++w8) { a0 += red[w8 * 1024 + tid]; a1 += red[w8 * 1024 + 512 + tid]; }
                  al[tid] = a0; al[512 + tid] = a1; }
                __syncthreads();
                for (int j = 0; j < 2; ++j) {
                    const int col = tid + 512 * j;
                    float w[16];
#pragma unroll
                    for (int r = 0; r < 16; ++r) w[r] = w_alpha[r * 1024 + col];
                    const float bias = b_alpha[col];
                    const bf16_t* kp = KB + (size_t)(item * 64) * 1024 + col;
                    float suf = 0.f;
                    for (int f8 = 7; f8 >= 0; --f8) {
                        float kd[8]; float kv[8];
#pragma unroll
                        for (int i = 0; i < 8; ++i) kv[i] = __uint_as_float(((unsigned)kp[(size_t)(f8 * 8 + i) * 1024]) << 16);
#pragma unroll
                        for (int i = 7; i >= 0; --i) { const int f = f8 * 8 + i;
                            const f32x4 a0 = al4[f * 4 + 0], a1 = al4[f * 4 + 1], a2 = al4[f * 4 + 2], a3 = al4[f * 4 + 3];
                            float z = bias;
                            z += a0.x * w[0] + a0.y * w[1] + a0.z * w[2] + a0.w * w[3];
                            z += a1.x * w[4] + a1.y * w[5] + a1.z * w[6] + a1.w * w[7];
                            z += a2.x * w[8] + a2.y * w[9] + a2.z * w[10] + a2.w * w[11];
                            z += a3.x * w[12] + a3.y * w[13] + a3.z * w[14] + a3.w * w[15];
                            const float ls = fminf(z, 0.f) - __logf(1.0f + __expf(-fabsf(z)));
                            kd[i] = kv[i] * __expf(suf);
                            suf += ls * 0.0625f; }
                        u32x4 o; o.x = cvt_pk_bf16(kd[0], kd[1]); o.y = cvt_pk_bf16(kd[2], kd[3]); o.z = cvt_pk_bf16(kd[4], kd[5]); o.w = cvt_pk_bf16(kd[6], kd[7]);
                        *(LAS u32x4*)(kimg + tid * 144 + f8 * 16) = o;
                    }
                    DEC[(size_t)item * 1024 + col] = __expf(suf);
                    __syncthreads();
                    {
                        u32x4* dst = (u32x4*)(KDT + (size_t)(item * 4 + 2 * j) * 256 * 64);
#pragma unroll
                        for (int i = 0; i < 8; ++i) { const int q = tid + 512 * i; dst[q] = *(const LAS u32x4*)(kimg + (q >> 3) * 144 + (q & 7) * 16); }
                    }
                    __syncthreads();
                }
            }
            __syncthreads();
        }
        {
            PHASE_IDS();
            for (int task = vcu2 * NTHREADS + tid; task < (M / 16) * 128; task += G * NTHREADS) {
                const int run = task >> 7, c8 = task & 127, ch = c8 * 8, gi = ch >> 8;
                const int t0 = run * 16, tp = t0 & (SEQ - 1);
                const bf16_t* up = UB + (size_t)t0 * 1024 + ch; bf16_t* dp = DB + (size_t)t0 * 1024 + ch;
                if (gi == 0) pool_task<2>(up, dp, tp); else if (gi == 1) pool_task<4>(up, dp, tp); else if (gi == 2) pool_task<8>(up, dp, tp); else pool_task<16>(up, dp, tp);
            }
        }
    }
    SEAM(2);

    if (IN(3)) for (int rep = 0; rep < REPS(3); ++rep) {
        PHASE_IDS();
        constexpr int KTP = 72, QP = 264, VTP = 72, OPP = 68;
        LAS bf16_t* KT = (LAS bf16_t*)lds;
        LAS bf16_t* QS = (LAS bf16_t*)(lds + 36864);
        LAS bf16_t* VT = (LAS bf16_t*)(lds + 36864 + 33792);
        LAS float* DC = (LAS float*)(lds + 36864 + 33792 + 9216);
        LAS float* OP = (LAS float*)(lds + 36864 + 33792 + 9216 + 1024);
        const int kh = wave >> 2, ng = wave & 3, l16 = lane & 15, g4 = lane >> 4;
        for (int wi = vcu2; wi < NB * 4 * 8; wi += G) {
            const int b = wi >> 5, hh = (wi >> 3) & 3, es = wi & 7;
            f32x4 S[8];
#pragma unroll
            for (int t = 0; t < 8; ++t) S[t] = (f32x4){0.f, 0.f, 0.f, 0.f};
            u32x4 rk[4], rq[4], rv, rgn, rgc; float rd = 0.f;
            float ngv[8];
            { const float* ngp = args.in[7] + hh * 512 + es * 64 + (tid & 7) * 8; const f32x4 n0 = *(const f32x4*)ngp, n1 = *(const f32x4*)(ngp + 4);
              ngv[0] = n0.x; ngv[1] = n0.y; ngv[2] = n0.z; ngv[3] = n0.w; ngv[4] = n1.x; ngv[5] = n1.y; ngv[6] = n1.z; ngv[7] = n1.w; }
#define SCAN_LOAD(c) do { const int _ci = b * 32 + (c); const size_t _row0 = (size_t)_ci * 64; \
            const u32x4* _kp = (const u32x4*)(KDT + (size_t)(_ci * 4 + hh) * 256 * 64); \
            _Pragma("unroll") for (int _i = 0; _i < 4; ++_i) rk[_i] = _kp[tid + 512 * _i]; \
            _Pragma("unroll") for (int _i = 0; _i < 4; ++_i) { const int _q = tid + 512 * _i, _f = _q >> 5, _p = _q & 31; rq[_i] = *(const u32x4*)(QB + (_row0 + _f) * 1024 + hh * 256 + _p * 8); } \
            rv = *(const u32x4*)(VB + (_row0 + lane) * 2048 + hh * 512 + es * 64 + wave * 8); \
            rgn = *(const u32x4*)(GB + (_row0 + (tid >> 3)) * 2048 + hh * 512 + es * 64 + (tid & 7) * 8); \
            if (tid < 256) rd = DEC[(size_t)_ci * 1024 + hh * 256 + tid]; } while (0)
            SCAN_LOAD(0);
            for (int c = 0; c < 32; ++c) {
#pragma unroll
                for (int i = 0; i < 4; ++i) { const int q = tid + 512 * i; *(LAS u32x4*)((LAS unsigned char*)KT + (q >> 3) * (KTP * 2) + (q & 7) * 16) = rk[i]; }
#pragma unroll
                for (int i = 0; i < 4; ++i) { const int q = tid + 512 * i; *(LAS u32x4*)((LAS unsigned char*)QS + (q >> 5) * (QP * 2) + (q & 31) * 16) = rq[i]; }
                { LAS bf16_t* vp = VT + (wave * 8) * VTP + lane;
                  vp[0 * VTP] = (bf16_t)(rv.x & 0xffffu); vp[1 * VTP] = (bf16_t)(rv.x >> 16); vp[2 * VTP] = (bf16_t)(rv.y & 0xffffu); vp[3 * VTP] = (bf16_t)(rv.y >> 16);
                  vp[4 * VTP] = (bf16_t)(rv.z & 0xffffu); vp[5 * VTP] = (bf16_t)(rv.z >> 16); vp[6 * VTP] = (bf16_t)(rv.w & 0xffffu); vp[7 * VTP] = (bf16_t)(rv.w >> 16); }
                if (tid < 256) DC[tid] = rd;
                rgc = rgn;
                __syncthreads();
                if (c + 1 < 32) SCAN_LOAD(c + 1);
                const bf16x8 bv0 = *(const LAS bf16x8*)(VT + (16 * ng + l16) * VTP + 8 * g4), bv1 = *(const LAS bf16x8*)(VT + (16 * ng + l16) * VTP + 32 + 8 * g4);
#pragma unroll
                for (int t = 0; t < 8; ++t) {
                    const f32x4 dc = *(const LAS f32x4*)(DC + 128 * kh + 16 * t + 4 * g4);
                    const bf16x8 a0 = *(const LAS bf16x8*)(KT + (128 * kh + 16 * t + l16) * KTP + 8 * g4), a1 = *(const LAS bf16x8*)(KT + (128 * kh + 16 * t + l16) * KTP + 32 + 8 * g4);
                    S[t] = S[t] * dc;
                    S[t] = __builtin_amdgcn_mfma_f32_16x16x32_bf16(a0, bv0, S[t], 0, 0, 0);
                    S[t] = __builtin_amdgcn_mfma_f32_16x16x32_bf16(a1, bv1, S[t], 0, 0, 0);
                }
                f32x4 o[4];
#pragma unroll
                for (int mt = 0; mt < 4; ++mt) o[mt] = (f32x4){0.f, 0.f, 0.f, 0.f};
#pragma unroll
                for (int s = 0; s < 4; ++s) {
                    u32x4 bw; bw.x = cvt_pk_bf16(S[2 * s][0], S[2 * s][1]); bw.y = cvt_pk_bf16(S[2 * s][2], S[2 * s][3]); bw.z = cvt_pk_bf16(S[2 * s + 1][0], S[2 * s + 1][1]); bw.w = cvt_pk_bf16(S[2 * s + 1][2], S[2 * s + 1][3]);
                    const bf16x8 bs = __builtin_bit_cast(bf16x8, bw);
#pragma unroll
                    for (int mt = 0; mt < 4; ++mt) {
                        const LAS bf16_t* qp = QS + (16 * mt + l16) * QP + 128 * kh + 32 * s + 4 * g4;
                        const u32x2 q0 = *(const LAS u32x2*)qp, q1 = *(const LAS u32x2*)(qp + 16);
                        u32x4 aw; aw.x = q0.x; aw.y = q0.y; aw.z = q1.x; aw.w = q1.y;
                        o[mt] = __builtin_amdgcn_mfma_f32_16x16x32_bf16(__builtin_bit_cast(bf16x8, aw), bs, o[mt], 0, 0, 0);
                    }
                }
#pragma unroll
                for (int mt = 0; mt < 4; ++mt)
#pragma unroll
                    for (int i = 0; i < 4; ++i) OP[kh * (64 * OPP) + (16 * mt + 4 * g4 + i) * OPP + 16 * ng + l16] = o[mt][i];
                __syncthreads();
                {
                    const int f = tid >> 3, d8 = (tid & 7) * 8;
                    const f32x4 p0 = *(const LAS f32x4*)(OP + f * OPP + d8), p1 = *(const LAS f32x4*)(OP + f * OPP + d8 + 4);
                    const f32x4 r0 = *(const LAS f32x4*)(OP + 64 * OPP + f * OPP + d8), r1 = *(const LAS f32x4*)(OP + 64 * OPP + f * OPP + d8 + 4);
                    const f32x4 v0 = p0 + r0, v1 = p1 + r1;
                    float ss = (v0[0] * v0[0] + v0[1] * v0[1]) + (v0[2] * v0[2] + v0[3] * v0[3]) + (v1[0] * v1[0] + v1[1] * v1[1]) + (v1[2] * v1[2] + v1[3] * v1[3]);
                    ss += __shfl_xor(ss, 1); ss += __shfl_xor(ss, 2); ss += __shfl_xor(ss, 4);
                    const size_t row = (size_t)(b * 32 + c) * 64 + f;
                    if ((tid & 7) == 0) SSP[row * 32 + hh * 8 + es] = ss;
                    const float gv[8] = {bflo(rgc.x), bfhi(rgc.x), bflo(rgc.y), bfhi(rgc.y), bflo(rgc.z), bfhi(rgc.z), bflo(rgc.w), bfhi(rgc.w)};
                    float og[8] = {v0[0], v0[1], v0[2], v0[3], v1[0], v1[1], v1[2], v1[3]};
#pragma unroll
                    for (int e = 0; e < 8; ++e) og[e] *= ngv[e] * gv[e] * fast_sigmoid(gv[e]);
                    u32x4 w; w.x = cvt_pk_bf16(og[0], og[1]); w.y = cvt_pk_bf16(og[2], og[3]); w.z = cvt_pk_bf16(og[4], og[5]); w.w = cvt_pk_bf16(og[6], og[7]);
                    *(u32x4*)(ONB + row * 2048 + hh * 512 + es * 64 + d8) = w;
                }
            }
#undef SCAN_LOAD
            __syncthreads();
        }
    }
    do { if (IN(3) && IN(5)) { xcd_barrier(gbar, MK_TID(wave_s) == 0, xloc != 0); } } while (0);

    if (IN(5)) for (int rep = 0; rep < REPS(5); ++rep) {
        pg8::StaticOrder S; S.init(M, DM, G, cid);
        {
            PHASE_IDS(); pg8::Unit u0; S.next(0, u0);
            if (tid < 256) { const f32x4* sp = (const f32x4*)(SSP + (size_t)(u0.pm * 256 + tid) * 32); float r[4];
#pragma unroll
                for (int h4 = 0; h4 < 4; ++h4) { const f32x4 s0 = sp[2 * h4], s1 = sp[2 * h4 + 1]; r[h4] = rsqrtf((((s0.x + s0.y) + (s0.z + s0.w)) + ((s1.x + s1.y) + (s1.z + s1.w))) * (1.0f / 512.0f) + EPS); }
                *(LAS f32x4*)(lds + pg8::STAGE_BYTES + tid * 16) = (f32x4){r[0] / r[1], r[1] / r[2], r[2] / r[3], r[3]}; }
            __syncthreads();
        }
        { pg8::Gemm g{ONB, WG_T, 2304, DM, 2304, 0, 0, DB, 1024}; EpiMixF E{GATES, MIXED, (const LAS float*)(lds + pg8::STAGE_BYTES)};
          pg8::gemm_phase<EpiMixF, true, pg8::StaticOrder, true, true>(lds, g, S, E, wave_s); }
    }
    SEAM(5);

    if (IN(6)) {
        pg8::Gemm g{MIXED, WOUT_T, DM, DM, DM, 0, 0}; pg8::StaticOrder S; S.init(M, DM, G, cid);
        EpiRes<true> E{x, X1N, RSS1};
        pg8::gemm_phase<EpiRes<true>>(lds, g, S, E, wave_s);
    }
    SEAM(6);

    if (IN(7)) for (int rep = 0; rep < REPS(7); ++rep) {
        pg8::Gemm g{X1N, WUP_T, DM, DM, DM, 0, 0}; pg8::StaticOrder S; S.init(M, FF, G, cid);
        EpiUp E{RSS1, UPACT};
        pg8::gemm_phase<EpiUp>(lds, g, S, E, wave_s);
#if PROBE_K == 1
        { EpiNull E0{RSS1}; pg8::gemm_phase<EpiNull>(lds, g, S, E0, wave_s); }
#elif PROBE_K == 2
        { FixedOrder S2; S2.init(M, FF, G, cid); EpiNull E0{RSS1}; pg8::gemm_phase<EpiNull, true, FixedOrder>(lds, g, S2, E0, wave_s); }
#endif
    }
    SEAM(7);

    if (IN(8)) {
        pg8::Gemm g{UPACT, WDN_T, FF, FF, FF, 0, 0}; pg8::StaticOrder S; S.init(M, DM, G, cid, 4);
        EpiRes<false> E{nullptr, X1N, RSS2};
        pg8::gemm_phase<EpiRes<false>>(lds, g, S, E, wave_s);
    }
    SEAM(8);

    if (IN(9)) {
        PHASE_IDS();
        const float* gf = args.in[13];
        for (int rr = 0; rr < (M / 256) / 8; rr += 2) {
            const int row0 = (M / 256) * vcu2 + wave + 8 * rr, row1 = row0 + 8;
            const u32x4* p0 = (const u32x4*)(X1N + (size_t)row0 * DM) + lane; const u32x4* p1 = (const u32x4*)(X1N + (size_t)row1 * DM) + lane;
            u32x4 a[4], b[4];
#pragma unroll
            for (int q = 0; q < 4; ++q) { a[q] = p0[64 * q]; b[q] = p1[64 * q]; }
            float sa = 0.f, sb = 0.f;
#pragma unroll
            for (int q = 0; q < 4; ++q) {
                sa += (bflo(a[q].x) * bflo(a[q].x) + bfhi(a[q].x) * bfhi(a[q].x)) + (bflo(a[q].y) * bflo(a[q].y) + bfhi(a[q].y) * bfhi(a[q].y)) + (bflo(a[q].z) * bflo(a[q].z) + bfhi(a[q].z) * bfhi(a[q].z)) + (bflo(a[q].w) * bflo(a[q].w) + bfhi(a[q].w) * bfhi(a[q].w));
                sb += (bflo(b[q].x) * bflo(b[q].x) + bfhi(b[q].x) * bfhi(b[q].x)) + (bflo(b[q].y) * bflo(b[q].y) + bfhi(b[q].y) * bfhi(b[q].y)) + (bflo(b[q].z) * bflo(b[q].z) + bfhi(b[q].z) * bfhi(b[q].z)) + (bflo(b[q].w) * bflo(b[q].w) + bfhi(b[q].w) * bfhi(b[q].w)); }
            const float ra = rsqrtf(wave_sum(sa) * (1.0f / DM) + EPS), rb = rsqrtf(wave_sum(sb) * (1.0f / DM) + EPS);
#pragma unroll
            for (int q = 0; q < 4; ++q) { const int c8 = 8 * (lane + 64 * q); const f32x4 g0 = *(const f32x4*)(gf + c8), g1 = *(const f32x4*)(gf + c8 + 4);
                float* o0 = args.out + (size_t)row0 * DM + c8; float* o1 = args.out + (size_t)row1 * DM + c8;
                *(f32x4*)o0 = (f32x4){bflo(a[q].x) * ra * g0.x, bfhi(a[q].x) * ra * g0.y, bflo(a[q].y) * ra * g0.z, bfhi(a[q].y) * ra * g0.w};
                *(f32x4*)(o0 + 4) = (f32x4){bflo(a[q].z) * ra * g1.x, bfhi(a[q].z) * ra * g1.y, bflo(a[q].w) * ra * g1.z, bfhi(a[q].w) * ra * g1.w};
                *(f32x4*)o1 = (f32x4){bflo(b[q].x) * rb * g0.x, bfhi(b[q].x) * rb * g0.y, bflo(b[q].y) * rb * g0.z, bfhi(b[q].y) * rb * g0.w};
                *(f32x4*)(o1 + 4) = (f32x4){bflo(b[q].z) * rb * g1.x, bfhi(b[q].z) * rb * g1.y, bflo(b[q].w) * rb * g1.z, bfhi(b[q].w) * rb * g1.w}; }
        }
    }
#undef IN
#undef SEAM
}

extern "C" void kernel_launch(void* const* d_in, const int* in_sizes, int n_in, void* d_out, int out_size, void* d_ws, size_t ws_size, hipStream_t stream) {
    static int grid = 0;
    if (grid == 0) {
        if (n_in != 14 || out_size != M * DM || ws_size < WS_END) { fprintf(stderr, "kernel_launch: unexpected shapes (n_in %d out %d ws %zu)\n", n_in, out_size, ws_size); grid = -1; return; }
        int dev = 0, cus = 0, per_cu = 0;
        (void)hipGetDevice(&dev); (void)hipDeviceGetAttribute(&cus, hipDeviceAttributeMultiprocessorCount, dev);
        if (hipFuncSetAttribute((const void*)mk_fwd, hipFuncAttributeMaxDynamicSharedMemorySize, LDS_BYTES) != hipSuccess) { fprintf(stderr, "kernel_launch: hipFuncSetAttribute failed\n"); grid = -1; return; }
        if (hipOccupancyMaxActiveBlocksPerMultiprocessor(&per_cu, (const void*)mk_fwd, NTHREADS, LDS_BYTES) != hipSuccess || per_cu < 1) per_cu = 1;
        (void)hipGetLastError();
        grid = cus * per_cu;
        if (grid > 256) grid = 256;
        fprintf(stderr, "kernel_launch: grid %d (cus %d per_cu %d) ws %zu\n", grid, cus, per_cu, ws_size);
    }
    if (grid < 0) return;
    if (hipMemsetAsync(d_ws, 0, WS_ZERO_BYTES, stream) != hipSuccess) { fprintf(stderr, "kernel_launch: hipMemsetAsync failed\n"); return; }
    Args a{};
    for (int i = 0; i < 14; ++i) a.in[i] = (const float*)d_in[i];
    a.out = (float*)d_out; a.ws = (unsigned char*)d_ws;
#if MK_N_LAUNCHES == 1
    a.ph_lo = 0; a.ph_hi = N_PHASES;
    void* kargs[] = {&a};
    hipError_t e = hipLaunchCooperativeKernel((const void*)mk_fwd, dim3(grid), dim3(NTHREADS), kargs, LDS_BYTES, stream);
    if (e != hipSuccess) fprintf(stderr, "kernel_launch: cooperative launch failed: %s (grid %d)\n", hipGetErrorString(e), grid);
#else
    for (int p = 0; p < N_PHASES; ++p) { a.ph_lo = p; a.ph_hi = p + 1; hipLaunchKernelGGL(mk_fwd, dim3(grid), dim3(NTHREADS), LDS_BYTES, stream, a); }
#endif
}
```

```cpp
#include <hip/hip_runtime.h>
#include <hip/hip_cooperative_groups.h>
#include <cstdio>
#include <cstdint>
namespace cg = cooperative_groups;

#ifndef MK_N_LAUNCHES
#define MK_N_LAUNCHES 1
#endif

#ifndef PROBE_K
#define PROBE_K 0
#endif
#ifndef PROBE_REP
#define PROBE_REP 0
#endif

#define LAS __attribute__((address_space(3)))
typedef unsigned short bf16_t;
typedef short bf16x8 __attribute__((ext_vector_type(8)));
typedef float f32x4 __attribute__((ext_vector_type(4)));
typedef unsigned u32x4 __attribute__((ext_vector_type(4)));
typedef unsigned u32x2 __attribute__((ext_vector_type(2)));

__device__ __forceinline__ unsigned cvt_pk_bf16(float lo, float hi) { unsigned r; asm volatile("v_cvt_pk_bf16_f32 %0, %1, %2" : "=v"(r) : "v"(lo), "v"(hi)); return r; }
__device__ __forceinline__ float bflo(unsigned u) { return __uint_as_float(u << 16); }
__device__ __forceinline__ float bfhi(unsigned u) { return __uint_as_float(u & 0xffff0000u); }
__device__ __forceinline__ float fast_sigmoid(float x) { return __builtin_amdgcn_rcpf(1.0f + __expf(-x)); }
#define LDS_WAIT() asm volatile("s_waitcnt lgkmcnt(0)" ::: "memory")
__device__ __forceinline__ int lane_id() { int r; asm volatile("v_mbcnt_lo_u32_b32 %0, -1, 0\n\tv_mbcnt_hi_u32_b32 %0, -1, %0" : "=v"(r)); return r; }
#define MK_TID(wave_s) ((wave_s) * 64 + lane_id())

namespace pg8 {
constexpr int BM = 256, BK = 64, HALF = 128, HTB = HALF * BK * 2, STAGE_BYTES = 8 * HTB, NXCD = 8, WGM = 8;
__host__ __device__ __forceinline__ int lds_byte(int r, int c) { const int st = (r >> 4) * 2 + (c >> 5), rr = r & 15, cc = c & 31, ob = rr * 64 + cc * 2; return st * 1024 + (ob ^ (((ob >> 9) & 1) << 5)); }
__host__ __device__ __forceinline__ void stage_rc(int b, int& R, int& C) { const int st = b / 1024, sb = b % 1024, swz = sb ^ (((sb >> 9) & 1) << 5); R = (st >> 1) * 16 + swz / 64; C = (st & 1) * 32 + (swz % 64) / 2; }
__host__ __device__ __forceinline__ int perm32(int rho) { const int n = rho >> 4, i = rho & 15; return 8 * (i >> 2) + 4 * n + (i & 3); }

struct Unit { int pm, pn; };
struct Gemm { const bf16_t* A; const bf16_t* Bt; int K, lda, ldb, a_shift, a_gstride; const bf16_t* P; int ldp; };

struct StaticOrder {
    int nM, nN, nwg, G, c, wgm;
    __host__ __device__ __forceinline__ void init(int M, int N, int G_, int c_, int wgm_ = WGM) { nM = M / BM; nN = N / BM; nwg = nM * nN; G = G_; c = c_; wgm = wgm_; }
    __host__ __device__ __forceinline__ bool next(int i, Unit& u) const {
        const long L = (long)i * G + c; if (L >= nwg) return false;
        int wgid = (int)L; { const int q = nwg / NXCD, r = nwg % NXCD, xcd = wgid % NXCD, off = wgid / NXCD; wgid = (xcd < r ? xcd * (q + 1) : r * (q + 1) + (xcd - r) * q) + off; }
        const int nig = wgm * nN, gid = wgid / nig, fm = gid * wgm, gsz = (nM - fm) < wgm ? (nM - fm) : wgm;
        u.pm = fm + ((wgid % nig) % gsz); u.pn = (wgid % nig) / gsz; return true;
    }
};

template <class Epi, bool ALIGN_EPI = true, class Sched = StaticOrder, bool RESCALE = false, bool POOLF = false>
__device__ __forceinline__ void gemm_phase(LAS unsigned char* lds, const Gemm g, const Sched& S, const Epi& E, const int wave_s) {
    int tid = MK_TID(wave_s); asm volatile("" : "+v"(tid));
    const int wid = wave_s, lane = tid & 63, wr = wid >> 2, wc = wid & 3, fr = lane & 15, fq = lane >> 4;
    const int K = g.K, nt = K / BK;
    unsigned voffA[2], voffB[2], voffP[2];
#pragma unroll
    for (int i = 0; i < 2; ++i) { int R, C; stage_rc(tid * 16 + i * 8192, R, C); const int Rb = (R & ~31) + perm32(R & 31);
        voffA[i] = (unsigned)(R * g.lda + C) * 2u; voffB[i] = (unsigned)(Rb * g.ldb + C) * 2u; voffP[i] = POOLF ? (unsigned)(R * g.ldp + C) * 2u : 0u; }
    const size_t hstepP = POOLF ? (size_t)HALF * g.ldp * 2 : 0;
    const size_t kstep = (size_t)(BK * 2);
    const size_t hstepA = (size_t)HALF * g.lda * 2, hstepB = (size_t)HALF * g.ldb * 2;
    const unsigned ldsw = (unsigned)wid * 1024u;
    const int aoff = lds_byte(wr * 64 + fr, fq * 8), boff = lds_byte(wc * 32 + fr, fq * 8);
#define PG8_SA(b, h) (((b) * 2 + (h)) * HTB)
#define PG8_SB(b, h) ((4 + (b) * 2 + (h)) * HTB)
#define PG8_STAGE(bufoff, gbase, voff) do { _Pragma("unroll") for (int _i = 0; _i < 2; ++_i) \
        __builtin_amdgcn_global_load_lds((const unsigned*)((const char*)(gbase) + (voff)[_i]), (LAS unsigned*)(lds + (bufoff) + ldsw + _i * 8192), 16, 0, 0); } while (0)
#define PG8_LDA(dst, b, h) do { _Pragma("unroll") for (int m = 0; m < 4; ++m) _Pragma("unroll") for (int k = 0; k < 2; ++k) dst[m][k] = *(const LAS bf16x8*)(lds + PG8_SA(b, h) + aoff + m * 2048 + k * 1024); } while (0)
#define PG8_LDB(dst, b, h) do { _Pragma("unroll") for (int n = 0; n < 2; ++n) _Pragma("unroll") for (int k = 0; k < 2; ++k) dst[n][k] = *(const LAS bf16x8*)(lds + PG8_SB(b, h) + boff + n * 2048 + k * 1024); } while (0)
#define PG8_MMA(ai, bj, At, Bt) do { __builtin_amdgcn_s_setprio(1); _Pragma("unroll") for (int m = 0; m < 4; ++m) _Pragma("unroll") for (int n = 0; n < 2; ++n) _Pragma("unroll") for (int k = 0; k < 2; ++k) \
        acc[ai][bj][m][n] = __builtin_amdgcn_mfma_f32_16x16x32_bf16(Bt[n][k], At[m][k], acc[ai][bj][m][n], 0, 0, 0); __builtin_amdgcn_s_setprio(0); } while (0)
#define PG8_WAIT_V(n) asm volatile("s_waitcnt vmcnt(" #n ")" ::: "memory")
#define PG8_WAIT_L(n) asm volatile("s_waitcnt lgkmcnt(" #n ")" ::: "memory")
#define PG8_BAR __builtin_amdgcn_s_barrier()
#define PG8_SCHED __builtin_amdgcn_sched_barrier(0)
    Unit cur, nxt; int ui = 0;
    if (!S.next(0, cur)) return;
    f32x4 acc[2][2][4][2];
#pragma unroll
    for (int a = 0; a < 2; ++a)
#pragma unroll
        for (int b = 0; b < 2; ++b)
#pragma unroll
            for (int m = 0; m < 4; ++m)
#pragma unroll
                for (int n = 0; n < 2; ++n) acc[a][b][m][n] = (f32x4){0.f, 0.f, 0.f, 0.f};
    bf16x8 At[4][2], B0[2][2], B1[2][2];
    const char* cA = (const char*)g.A + (size_t)cur.pm * 2 * hstepA + (size_t)((cur.pn >> g.a_shift) * g.a_gstride) * 2;
    const char* cB = (const char*)g.Bt + (size_t)cur.pn * 2 * hstepB;
    const char* cP = POOLF ? (const char*)g.P + (size_t)cur.pm * 2 * hstepP + (size_t)((cur.pn >> 1) * 256) * 2 : cA;
    if constexpr (POOLF) {
    PG8_STAGE(PG8_SB(0, 0), cB, voffB); PG8_STAGE(PG8_SB(0, 1), cB + hstepB, voffB); PG8_STAGE(PG8_SA(0, 0), cP, voffP); PG8_STAGE(PG8_SA(0, 1), cP + hstepP, voffP);
    if (wr == 1) PG8_BAR;
    PG8_WAIT_V(2); PG8_BAR;
    PG8_STAGE(PG8_SB(1, 0), cB + kstep, voffB); PG8_STAGE(PG8_SA(1, 0), cP + kstep, voffP); PG8_STAGE(PG8_SB(1, 1), cB + hstepB + kstep, voffB);
    PG8_WAIT_V(6); PG8_BAR;
    } else {
    PG8_STAGE(PG8_SB(0, 0), cB, voffB); PG8_STAGE(PG8_SB(0, 1), cB + hstepB, voffB); PG8_STAGE(PG8_SA(0, 0), cA, voffA); PG8_STAGE(PG8_SA(0, 1), cA + hstepA, voffA);
    if (wr == 1) PG8_BAR;
    PG8_WAIT_V(2); PG8_BAR;
    PG8_STAGE(PG8_SB(1, 0), cB + kstep, voffB); PG8_STAGE(PG8_SA(1, 0), cA + kstep, voffA); PG8_STAGE(PG8_SB(1, 1), cB + hstepB + kstep, voffB);
    PG8_WAIT_V(6); PG8_BAR;
    }
    for (;;) {
        const bool has_next = S.next(ui + 1, nxt);
        const char* nA = has_next ? (const char*)g.A + (size_t)nxt.pm * 2 * hstepA + (size_t)((nxt.pn >> g.a_shift) * g.a_gstride) * 2 : cA;
        const char* nB = has_next ? (const char*)g.Bt + (size_t)nxt.pn * 2 * hstepB : cB;
        const char* nP = (POOLF && has_next) ? (const char*)g.P + (size_t)nxt.pm * 2 * hstepP + (size_t)((nxt.pn >> 1) * 256) * 2 : cP;
        for (int t = 0; t < nt; t += 2) {
            const bool last = (t == nt - 2);
            const char* a1; const char* a2; bool k1 = false, k2 = false;
            if constexpr (POOLF) {
                k1 = (t + 1 < 4); k2 = (t + 2 < 4) || last;
                a1 = k1 ? cP + (size_t)(t + 1) * kstep : cA + (size_t)(t + 1 - 4) * kstep;
                a2 = last ? nP : (k2 ? cP + (size_t)(t + 2) * kstep : cA + (size_t)(t + 2 - 4) * kstep);
            } else { a1 = cA + (size_t)(t + 1) * kstep; a2 = last ? nA : cA + (size_t)(t + 2) * kstep; }
            const char* b2 = last ? nB : cB + (size_t)(t + 2) * kstep;
            const char* a3 = a2 + kstep; const char* b3 = b2 + kstep;
            const unsigned v1[2] = {k1 ? voffP[0] : voffA[0], k1 ? voffP[1] : voffA[1]}, v2[2] = {k2 ? voffP[0] : voffA[0], k2 ? voffP[1] : voffA[1]};
            const size_t h1 = k1 ? hstepP : hstepA, h2 = k2 ? hstepP : hstepA;
            if constexpr (POOLF) { if (t == 4) { int frl = fr; asm volatile("" : "+v"(frl)); E.mid(acc, cur, wr, wc, frl, fq); } }
            if constexpr (RESCALE) {
                constexpr int T0 = POOLF ? 4 : 0;
                if (t > T0 && ((t - T0) & 7) == 0) { const LAS float* rt = (const LAS float*)(lds + STAGE_BYTES) + (((t - T0) >> 3) - 1);
#pragma unroll
                    for (int a = 0; a < 2; ++a)
#pragma unroll
                        for (int m = 0; m < 4; ++m) { const float f = rt[(a * 128 + wr * 64 + m * 16 + fr) * 4];
#pragma unroll
                            for (int b = 0; b < 2; ++b) { acc[a][b][m][0] *= f; acc[a][b][m][1] *= f; } } }
            }
            PG8_LDB(B0, 0, 0); PG8_LDB(B1, 0, 1); PG8_SCHED; PG8_LDA(At, 0, 0); PG8_STAGE(PG8_SA(1, 1), a1 + h1, v1);
            PG8_WAIT_V(8); PG8_WAIT_L(0); PG8_BAR; PG8_MMA(0, 0, At, B0); PG8_MMA(0, 1, At, B1); PG8_BAR; PG8_SCHED;
            PG8_LDA(At, 0, 1); PG8_STAGE(PG8_SB(0, 0), b2, voffB); PG8_STAGE(PG8_SB(0, 1), b2 + hstepB, voffB); PG8_STAGE(PG8_SA(0, 0), a2, v2);
            PG8_WAIT_V(8); PG8_WAIT_L(0); PG8_BAR; PG8_MMA(1, 0, At, B0); PG8_MMA(1, 1, At, B1); PG8_BAR; PG8_SCHED;
            PG8_LDB(B0, 1, 0); PG8_LDB(B1, 1, 1); PG8_SCHED; PG8_LDA(At, 1, 0); PG8_STAGE(PG8_SA(0, 1), a2 + h2, v2);
            PG8_WAIT_V(8); PG8_WAIT_L(0); PG8_BAR; PG8_MMA(0, 0, At, B0); PG8_MMA(0, 1, At, B1); PG8_BAR; PG8_SCHED;
            PG8_LDA(At, 1, 1); PG8_STAGE(PG8_SB(1, 0), b3, voffB); PG8_STAGE(PG8_SB(1, 1), b3 + hstepB, voffB); PG8_STAGE(PG8_SA(1, 0), a3, v2);
            PG8_WAIT_V(8); PG8_WAIT_L(0); PG8_BAR; PG8_MMA(1, 0, At, B0); PG8_MMA(1, 1, At, B1); PG8_BAR; PG8_SCHED;
        }
        if constexpr (ALIGN_EPI) { if (wr == 0) PG8_BAR; }
        E(acc, cur, wr, wc, fr, fq);
        if (!has_next) break;
#pragma unroll
        for (int a = 0; a < 2; ++a)
#pragma unroll
            for (int b = 0; b < 2; ++b)
#pragma unroll
                for (int m = 0; m < 4; ++m)
#pragma unroll
                    for (int n = 0; n < 2; ++n) acc[a][b][m][n] = (f32x4){0.f, 0.f, 0.f, 0.f};
        cur = nxt; cA = nA; cB = nB; cP = nP; ++ui;
        if constexpr (ALIGN_EPI) { if (wr == 1) PG8_BAR; }
    }
    PG8_WAIT_V(0);
    if constexpr (!ALIGN_EPI) { if (wr == 0) PG8_BAR; }
    PG8_BAR;
#undef PG8_SA
#undef PG8_SB
#undef PG8_STAGE
#undef PG8_LDA
#undef PG8_LDB
#undef PG8_MMA
#undef PG8_WAIT_V
#undef PG8_WAIT_L
#undef PG8_BAR
#undef PG8_SCHED
}
}


#define XB_TMO      128
#define XB_XCNT(j)  (256  + 64 * (j))
#define XB_XSUB(j)  (1280 + 64 * (j))
#define XB_XGEN(j)  (2304 + 64 * (j))
#define XB_TOP      3328
#define XB_TOPGEN   3392
#define XCD_BAR_WORDS 3456
#define XB_SPIN_CAP (1u << 18)
__device__ __forceinline__ unsigned xb_ld(unsigned* p)              { return __hip_atomic_load(p, __ATOMIC_RELAXED, __HIP_MEMORY_SCOPE_AGENT); }
__device__ __forceinline__ unsigned xb_add(unsigned* p, unsigned v) { return __hip_atomic_fetch_add(p, v, __ATOMIC_RELAXED, __HIP_MEMORY_SCOPE_AGENT); }
__device__ __forceinline__ unsigned xb_xcc_id() { return (unsigned)__builtin_amdgcn_s_getreg((3 << 11) | 20) & 0xFu; }
#define XB_SPIN(cond, bar) do { unsigned _sp = 0; while (cond) { __builtin_amdgcn_s_sleep(1); \
    if ((++_sp & 255u) == 0u) { if (xb_ld(&(bar)[XB_TMO])) break; if (_sp > XB_SPIN_CAP) { atomicAdd(&(bar)[XB_TMO], 1u); break; } } } } while (0)
struct XcdBarrier { unsigned* bar; unsigned x; volatile LAS unsigned* st; };
__device__ __forceinline__ XcdBarrier xcd_barrier_post(unsigned* bar, volatile LAS unsigned* st, const bool t0) {
    XcdBarrier b; b.bar = bar; b.x = xb_xcc_id(); b.st = st;
    if (t0) st[3] = xb_add(&bar[XB_XCNT(b.x)], 1u);
    return b;
}
__device__ __forceinline__ void xcd_barrier_complete(unsigned* bar, unsigned x, unsigned& nloc, unsigned& nx, unsigned& even) {
    const unsigned G = gridDim.x * gridDim.y * gridDim.z;
    unsigned sum, cnt, mine, ok8, sp = 0u;
    for (;;) {
        sum = 0u; cnt = 0u; mine = 0u; ok8 = 0u;
#pragma unroll
        for (unsigned j = 0; j < 16; ++j) { const unsigned c = xb_ld(&bar[XB_XCNT(j)]); sum += c; cnt += (c > 0u) ? 1u : 0u; mine = (j == x) ? c : mine; ok8 += (j < 8u && c * 8u == G) ? 1u : 0u; }
        if (sum == G) break;
        __builtin_amdgcn_s_sleep(1);
        if ((++sp & 255u) == 0u) { if (xb_ld(&bar[XB_TMO])) break; if (sp > XB_SPIN_CAP) { atomicAdd(&bar[XB_TMO], 1u); break; } }
    }
    nloc = mine > 0u ? mine : 1u; nx = cnt > 0u ? cnt : 1u; even = (sum == G && ok8 == 8u) ? 1u : 0u;
}
__device__ __forceinline__ void xcd_barrier(const XcdBarrier& b, const bool t0, const bool local) {
    asm volatile("s_waitcnt vmcnt(0)" ::: "memory");
    __syncthreads();
    if (t0) {
        unsigned* bar = b.bar;
        __builtin_amdgcn_s_waitcnt(0);
        unsigned nloc = b.st[0], nx = b.st[1];
        if (nloc == 0u) { unsigned even; xcd_barrier_complete(bar, b.x, nloc, nx, even); b.st[0] = nloc; b.st[1] = nx; b.st[2] = even; }
        const unsigned old = xb_add(&bar[XB_XSUB(b.x)], 1u);
        const unsigned gen = old / nloc;
        if (old + 1u == (gen + 1u) * nloc) {
            if (!local) {
            __builtin_amdgcn_fence(__ATOMIC_RELEASE, "agent");
            asm volatile("s_waitcnt vmcnt(0)" ::: "memory");
            const unsigned og = xb_add(&bar[XB_TOP], 1u);
            const unsigned tg = og / nx;
            if (og + 1u == (tg + 1u) * nx) xb_add(&bar[XB_TOPGEN], 1u);
            else XB_SPIN(xb_ld(&bar[XB_TOPGEN]) == tg, bar);
            }
            __builtin_amdgcn_fence(__ATOMIC_ACQUIRE, "agent");
            xb_add(&bar[XB_XGEN(b.x)], 1u);
            asm volatile("s_waitcnt vmcnt(0)" ::: "memory");
        } else {
            XB_SPIN(xb_ld(&bar[XB_XGEN(b.x)]) == gen, bar);
            __builtin_amdgcn_fence(__ATOMIC_ACQUIRE, "agent");
            asm volatile("s_waitcnt vmcnt(0)" ::: "memory");
        }
    }
    __syncthreads();
}

constexpr int DM = 2048, SEQ = 2048, NB = 8, M = NB * SEQ, INW = 11280, FF = 8192, NPROJ_T = 44;
constexpr float EPS = 1e-6f;
constexpr size_t MiB = 1u << 20;
constexpr size_t WS_RSS1 = 0, WS_RSS2 = 64 * 1024, WS_BAR = 128 * 1024, WS_ZERO_BYTES = 160 * 1024;
constexpr size_t WS_WIN = 1 * MiB, WS_WOUT = 46 * MiB, WS_H = 54 * MiB, WS_WUP = 54 * MiB, WS_WDN = 86 * MiB;
constexpr size_t WS_U = 118 * MiB, WS_KDT = 150 * MiB, WS_Q = 182 * MiB, WS_K = 214 * MiB, WS_V = 246 * MiB, WS_G = 310 * MiB, WS_GATES = 374 * MiB, WS_END = 502 * MiB;
constexpr size_t WS_X1N = 118 * MiB, WS_MIXED = 182 * MiB, WS_UPACT = 246 * MiB;
constexpr size_t DO_ON = 0, DO_D = 64 * MiB, DO_WG = 96 * MiB  , DO_SS = 105 * MiB, DO_ALOW = 107 * MiB, DO_DEC = 108 * MiB;

constexpr int LDS_BYTES = 147456;
constexpr int NTHREADS = 512;

struct EpiProj {
    unsigned char* ws;
    __device__ __forceinline__ void operator()(const f32x4 (&acc)[2][2][4][2], const pg8::Unit& u, int wr, int wc, int fr, int fq) const {
        const int pn = u.pn; const int row0 = u.pm * 256 + wr * 64 + fr;
        bf16_t* base; int ld, ct; float sc = 1.f; bool sig = false;
        if (pn < 4) { base = (bf16_t*)(ws + WS_U); ld = 1024; ct = pn; }
        else if (pn < 8) { base = (bf16_t*)(ws + WS_Q); ld = 1024; ct = pn - 4; sc = 0.0625f; }
        else if (pn < 12) { base = (bf16_t*)(ws + WS_K); ld = 1024; ct = pn - 8; }
        else if (pn < 20) { base = (bf16_t*)(ws + WS_V); ld = 2048; ct = pn - 12; }
        else if (pn < 28) { base = (bf16_t*)(ws + WS_G); ld = 2048; ct = pn - 20; }
        else { base = (bf16_t*)(ws + WS_GATES); ld = 4096; ct = pn - 28; sig = true; }
        const int col0 = ct * 256 + wc * 32 + 8 * fq;
#pragma unroll
        for (int ai = 0; ai < 2; ++ai)
#pragma unroll
            for (int m = 0; m < 4; ++m) { bf16_t* rowp = base + (size_t)(row0 + ai * 128 + m * 16) * ld + col0;
#pragma unroll
                for (int bj = 0; bj < 2; ++bj) { f32x4 v0 = acc[ai][bj][m][0] * sc, v1 = acc[ai][bj][m][1] * sc;
                    if (sig) {
#pragma unroll
                        for (int j = 0; j < 4; ++j) { v0[j] = fast_sigmoid(v0[j]); v1[j] = fast_sigmoid(v1[j]); } }
                    u32x4 w; w.x = cvt_pk_bf16(v0[0], v0[1]); w.y = cvt_pk_bf16(v0[2], v0[3]); w.z = cvt_pk_bf16(v1[0], v1[1]); w.w = cvt_pk_bf16(v1[2], v1[3]);
                    *(u32x4*)(rowp + bj * 128) = w; } }
    }
};
struct EpiMixF {
    const bf16_t* gates; bf16_t* mixed; const LAS float* rt;
    __device__ __forceinline__ void mid(f32x4 (&acc)[2][2][4][2], const pg8::Unit& u, int wr, int wc, int fr, int fq) const {
        const int row0 = u.pm * 256 + wr * 64 + fr, col0 = u.pn * 256 + wc * 32 + 8 * fq;
#pragma unroll
        for (int ai = 0; ai < 2; ++ai)
#pragma unroll
            for (int m = 0; m < 4; ++m) { const size_t r = (size_t)(row0 + ai * 128 + m * 16);
                const f32x4 t4 = *(const LAS f32x4*)(rt + (ai * 128 + wr * 64 + m * 16 + fr) * 4); const float ir0 = __builtin_amdgcn_rcpf(t4.x * t4.y * t4.z * t4.w);
#pragma unroll
                for (int bj = 0; bj < 2; ++bj) { const u32x4 pw = *(const u32x4*)(gates + r * 4096 + col0 + bj * 128), gw = *(const u32x4*)(gates + r * 4096 + 2048 + col0 + bj * 128);
                    f32x4 f0, f1;
                    f0[0] = bflo(pw.x) * ir0 * __builtin_amdgcn_rcpf(fmaxf(bflo(gw.x), 1e-20f)); f0[1] = bfhi(pw.x) * ir0 * __builtin_amdgcn_rcpf(fmaxf(bfhi(gw.x), 1e-20f));
                    f0[2] = bflo(pw.y) * ir0 * __builtin_amdgcn_rcpf(fmaxf(bflo(gw.y), 1e-20f)); f0[3] = bfhi(pw.y) * ir0 * __builtin_amdgcn_rcpf(fmaxf(bfhi(gw.y), 1e-20f));
                    f1[0] = bflo(pw.z) * ir0 * __builtin_amdgcn_rcpf(fmaxf(bflo(gw.z), 1e-20f)); f1[1] = bfhi(pw.z) * ir0 * __builtin_amdgcn_rcpf(fmaxf(bfhi(gw.z), 1e-20f));
                    f1[2] = bflo(pw.w) * ir0 * __builtin_amdgcn_rcpf(fmaxf(bflo(gw.w), 1e-20f)); f1[3] = bfhi(pw.w) * ir0 * __builtin_amdgcn_rcpf(fmaxf(bfhi(gw.w), 1e-20f));
                    acc[ai][bj][m][0] *= f0; acc[ai][bj][m][1] *= f1; } }
    }
    __device__ __forceinline__ void operator()(const f32x4 (&acc)[2][2][4][2], const pg8::Unit& u, int wr, int wc, int fr, int fq) const {
        const int row0 = u.pm * 256 + wr * 64 + fr, col0 = u.pn * 256 + wc * 32 + 8 * fq;
#pragma unroll
        for (int ai = 0; ai < 2; ++ai)
#pragma unroll
            for (int m = 0; m < 4; ++m) { const size_t r = (size_t)(row0 + ai * 128 + m * 16);
                const float r3 = rt[(ai * 128 + wr * 64 + m * 16 + fr) * 4 + 3];
#pragma unroll
                for (int bj = 0; bj < 2; ++bj) { const u32x4 gw = *(const u32x4*)(gates + r * 4096 + 2048 + col0 + bj * 128);
                    const f32x4 v0 = acc[ai][bj][m][0] * r3, v1 = acc[ai][bj][m][1] * r3;
                    u32x4 w; w.x = cvt_pk_bf16(v0[0] * fmaxf(bflo(gw.x), 1e-20f), v0[1] * fmaxf(bfhi(gw.x), 1e-20f)); w.y = cvt_pk_bf16(v0[2] * fmaxf(bflo(gw.y), 1e-20f), v0[3] * fmaxf(bfhi(gw.y), 1e-20f));
                    w.z = cvt_pk_bf16(v1[0] * fmaxf(bflo(gw.z), 1e-20f), v1[1] * fmaxf(bfhi(gw.z), 1e-20f)); w.w = cvt_pk_bf16(v1[2] * fmaxf(bflo(gw.w), 1e-20f), v1[3] * fmaxf(bfhi(gw.w), 1e-20f));
                    *(u32x4*)(mixed + r * 2048 + col0 + bj * 128) = w; } }
    }
};
template <bool FIRST> struct EpiRes {
    const float* xin; bf16_t* xs; float* rss;
    __device__ __forceinline__ void operator()(const f32x4 (&acc)[2][2][4][2], const pg8::Unit& u, int wr, int wc, int fr, int fq) const {
        const int row0 = u.pm * 256 + wr * 64 + fr, col0 = u.pn * 256 + wc * 32 + 8 * fq;
#pragma unroll
        for (int ai = 0; ai < 2; ++ai)
#pragma unroll
            for (int m = 0; m < 4; ++m) { const size_t r = (size_t)(row0 + ai * 128 + m * 16); float ss = 0.f;
#pragma unroll
                for (int bj = 0; bj < 2; ++bj) { const size_t off = r * 2048 + col0 + bj * 128;
                    f32x4 x0, x1;
                    if (FIRST) { x0 = *(const f32x4*)(xin + off); x1 = *(const f32x4*)(xin + off + 4); }
                    else { const u32x4 xw = *(const u32x4*)(xs + off); x0 = (f32x4){bflo(xw.x), bfhi(xw.x), bflo(xw.y), bfhi(xw.y)}; x1 = (f32x4){bflo(xw.z), bfhi(xw.z), bflo(xw.w), bfhi(xw.w)}; }
                    const f32x4 v0 = x0 + acc[ai][bj][m][0], v1 = x1 + acc[ai][bj][m][1];
                    u32x4 w; w.x = cvt_pk_bf16(v0[0], v0[1]); w.y = cvt_pk_bf16(v0[2], v0[3]); w.z = cvt_pk_bf16(v1[0], v1[1]); w.w = cvt_pk_bf16(v1[2], v1[3]); *(u32x4*)(xs + off) = w;
                    if (FIRST) ss += (v0[0] * v0[0] + v0[1] * v0[1]) + (v0[2] * v0[2] + v0[3] * v0[3]) + (v1[0] * v1[0] + v1[1] * v1[1]) + (v1[2] * v1[2] + v1[3] * v1[3]); }
                if (FIRST) { ss += __shfl_xor(ss, 16); ss += __shfl_xor(ss, 32);
                    if (fq == 0) unsafeAtomicAdd(rss + r, ss); } }
    }
};
struct EpiUp {
    const float* rss; bf16_t* up;
    __device__ __forceinline__ void operator()(const f32x4 (&acc)[2][2][4][2], const pg8::Unit& u, int wr, int wc, int fr, int fq) const {
        const int row0 = u.pm * 256 + wr * 64 + fr, col0 = u.pn * 256 + wc * 32 + 8 * fq;
#pragma unroll
        for (int ai = 0; ai < 2; ++ai)
#pragma unroll
            for (int m = 0; m < 4; ++m) { const size_t r = (size_t)(row0 + ai * 128 + m * 16);
                const float rs = rsqrtf(rss[r] * (1.0f / DM) + EPS);
#pragma unroll
                for (int bj = 0; bj < 2; ++bj) { f32x4 v0 = acc[ai][bj][m][0] * rs, v1 = acc[ai][bj][m][1] * rs;
#pragma unroll
                    for (int j = 0; j < 4; ++j) { v0[j] = fmaxf(v0[j], 0.f); v0[j] *= v0[j]; v1[j] = fmaxf(v1[j], 0.f); v1[j] *= v1[j]; }
                    u32x4 w; w.x = cvt_pk_bf16(v0[0], v0[1]); w.y = cvt_pk_bf16(v0[2], v0[3]); w.z = cvt_pk_bf16(v1[0], v1[1]); w.w = cvt_pk_bf16(v1[2], v1[3]);
                    *(u32x4*)(up + r * FF + col0 + bj * 128) = w; } }
    }
};


#if PROBE_K
struct EpiNull { float* sink;
    __device__ __forceinline__ void operator()(const f32x4 (&acc)[2][2][4][2], const pg8::Unit& u, int wr, int wc, int fr, int fq) const {
        f32x4 t = (f32x4){0.f, 0.f, 0.f, 0.f};
#pragma unroll
        for (int ai = 0; ai < 2; ++ai)
#pragma unroll
            for (int bj = 0; bj < 2; ++bj)
#pragma unroll
                for (int m = 0; m < 4; ++m) { t += acc[ai][bj][m][0]; t += acc[ai][bj][m][1]; }
        if (t[0] + t[1] + t[2] + t[3] == 123456.789f) sink[0] = t[0];
    }
};
struct FixedOrder : pg8::StaticOrder {
    __device__ bool next(int i, pg8::Unit& u) const { const bool r = pg8::StaticOrder::next(i, u); u.pm = 0; u.pn = 0; return r; }
};
#endif

__device__ __forceinline__ float wave_sum(float v) {
#pragma unroll
    for (int o = 1; o < 64; o <<= 1) v += __shfl_xor(v, o);
    return v;
}
template <bool NTS = false> __device__ __forceinline__ void transpose_item(const float* __restrict__ W, int ldw, int col0, int nvalid, const float* __restrict__ kscale, const float* __restrict__ nscale,
                                               bf16_t* __restrict__ WT, int ldt, int row0, int k0, LAS float* scr, int lane) {
    const int nl = lane & 31;
    float tv[32];
#pragma unroll
    for (int i = 0; i < 32; ++i) { const int kk = 2 * i + (lane >> 5); tv[i] = (nl < nvalid) ? __builtin_nontemporal_load(W + (size_t)(k0 + kk) * ldw + col0 + nl) : 0.f; }
    if (kscale) {
#pragma unroll
        for (int i = 0; i < 32; ++i) tv[i] *= kscale[k0 + 2 * i + (lane >> 5)]; }
#pragma unroll
    for (int i = 0; i < 32; ++i) scr[(2 * i + (lane >> 5)) * 33 + nl] = tv[i];
    LDS_WAIT();
    const int c = lane & 7;
#pragma unroll
    for (int j = 0; j < 4; ++j) { const int n = (lane >> 3) + 8 * j; const LAS float* s = scr + (8 * c) * 33 + n;
        const float ns = nscale ? nscale[row0 + n] : 1.0f;
        u32x4 o; o.x = cvt_pk_bf16(s[0 * 33] * ns, s[1 * 33] * ns); o.y = cvt_pk_bf16(s[2 * 33] * ns, s[3 * 33] * ns); o.z = cvt_pk_bf16(s[4 * 33] * ns, s[5 * 33] * ns); o.w = cvt_pk_bf16(s[6 * 33] * ns, s[7 * 33] * ns);
        if (NTS) __builtin_nontemporal_store(o, (u32x4*)(WT + (size_t)(row0 + n) * ldt + k0 + 8 * c)); else *(u32x4*)(WT + (size_t)(row0 + n) * ldt + k0 + 8 * c) = o; }
    LDS_WAIT();
}


template <int W> __device__ __forceinline__ void pool_task(const bf16_t* __restrict__ up, bf16_t* __restrict__ dp, int tp) {
    u32x4 r[W - 1 + 16];
#pragma unroll
    for (int j = 0; j < W - 1; ++j) r[j] = (tp - (W - 1) + j >= 0) ? *(const u32x4*)(up + (ptrdiff_t)(j - (W - 1)) * 1024) : (u32x4){0u, 0u, 0u, 0u};
#pragma unroll
    for (int i = 0; i < 16; ++i) r[W - 1 + i] = *(const u32x4*)(up + (size_t)i * 1024);
    float s[8];
#pragma unroll
    for (int e = 0; e < 8; ++e) s[e] = 0.f;
#pragma unroll
    for (int j = 0; j < W - 1; ++j) { s[0] += bflo(r[j].x); s[1] += bfhi(r[j].x); s[2] += bflo(r[j].y); s[3] += bfhi(r[j].y); s[4] += bflo(r[j].z); s[5] += bfhi(r[j].z); s[6] += bflo(r[j].w); s[7] += bfhi(r[j].w); }
#pragma unroll
    for (int i = 0; i < 16; ++i) {
        const u32x4 uu = r[W - 1 + i];
        const float uf[8] = {bflo(uu.x), bfhi(uu.x), bflo(uu.y), bfhi(uu.y), bflo(uu.z), bfhi(uu.z), bflo(uu.w), bfhi(uu.w)};
        const int cnt = (tp + i + 1) < W ? (tp + i + 1) : W; const float inv = 1.0f / (float)cnt;
        float d[8];
#pragma unroll
        for (int e = 0; e < 8; ++e) { s[e] += uf[e]; d[e] = s[e] * inv - uf[e]; }
        u32x4 o; o.x = cvt_pk_bf16(d[0], d[1]); o.y = cvt_pk_bf16(d[2], d[3]); o.z = cvt_pk_bf16(d[4], d[5]); o.w = cvt_pk_bf16(d[6], d[7]);
        *(u32x4*)(dp + (size_t)i * 1024) = o;
        const u32x4 ub = r[i];
        s[0] -= bflo(ub.x); s[1] -= bfhi(ub.x); s[2] -= bflo(ub.y); s[3] -= bfhi(ub.y); s[4] -= bflo(ub.z); s[5] -= bfhi(ub.z); s[6] -= bflo(ub.w); s[7] -= bfhi(ub.w);
    }
}

struct Args { const float* in[14]; float* out; unsigned char* ws; int ph_lo, ph_hi; };
constexpr int N_PHASES = 10;

__global__ void __launch_bounds__(NTHREADS, 2) mk_fwd(Args args) {
    extern __shared__ __attribute__((aligned(16))) unsigned char lds_raw[];
    LAS unsigned char* lds = (LAS unsigned char*)lds_raw;
    const int wave_s = __builtin_amdgcn_readfirstlane((int)threadIdx.x >> 6);
#define PHASE_IDS() int tid = MK_TID(wave_s); asm volatile("" : "+v"(tid)); const int lane = tid & 63, wave = wave_s; (void)lane; (void)wave
    const int G = gridDim.x, bx = blockIdx.x;
    const int vcu = (G % 8 == 0) ? (bx % 8) * (G / 8) + bx / 8 : bx;
    unsigned char* ws = args.ws; unsigned char* dob = (unsigned char*)args.out;
    const float* x = args.in[0];
    const int lo = args.ph_lo, hi = args.ph_hi;
#define IN(k) (lo <= (k) && (k) < hi)
    volatile LAS unsigned* bst = (volatile LAS unsigned*)(lds + LDS_BYTES - 16);
    if (MK_TID(wave_s) < 4) bst[MK_TID(wave_s)] = 0u;
    __syncthreads();
    XcdBarrier gbar; gbar.bar = (unsigned*)(ws + WS_BAR); gbar.x = 0; gbar.st = bst;
    if (hi - lo > 1) gbar = xcd_barrier_post((unsigned*)(ws + WS_BAR), bst, MK_TID(wave_s) == 0);
    if (lo < 0) cg::this_grid().sync();
#define SEAM(k) do { if (IN(k) && IN((k) + 1)) { xcd_barrier(gbar, MK_TID(wave_s) == 0, (k) > 0 && xloc != 0); } } while (0)
    int xloc = 0, vcu2 = vcu, cid = bx;
#define REPS(k) (((PROBE_REP >> (k)) & 1) ? 2 : 1)

    bf16_t* const WIN_T = (bf16_t*)(ws + WS_WIN); bf16_t* const WOUT_T = (bf16_t*)(ws + WS_WOUT); bf16_t* const WUP_T = (bf16_t*)(ws + WS_WUP); bf16_t* const WDN_T = (bf16_t*)(ws + WS_WDN);
    bf16_t* const HB = (bf16_t*)((unsigned char*)args.out + DO_ON);     bf16_t* const UB = (bf16_t*)(ws + WS_U); bf16_t* const KDT = (bf16_t*)(ws + WS_KDT);
    bf16_t* const QB = (bf16_t*)(ws + WS_Q); bf16_t* const KB = (bf16_t*)(ws + WS_K); bf16_t* const VB = (bf16_t*)(ws + WS_V); bf16_t* const GB = (bf16_t*)(ws + WS_G);
    bf16_t* const GATES = (bf16_t*)(ws + WS_GATES); bf16_t* const X1N = (bf16_t*)(ws + WS_X1N); bf16_t* const MIXED = (bf16_t*)(ws + WS_MIXED); bf16_t* const UPACT = (bf16_t*)(ws + WS_UPACT);
    float* const RSS1 = (float*)(ws + WS_RSS1); float* const RSS2 = (float*)(ws + WS_RSS2);
    bf16_t* const ONB = (bf16_t*)(dob + DO_ON); bf16_t* const DB = (bf16_t*)(dob + DO_D); bf16_t* const WG_T = (bf16_t*)(dob + DO_WG);
    float* const SSP = (float*)(dob + DO_SS); float* const DEC = (float*)(dob + DO_DEC);

    if (IN(0)) for (int rep = 0; rep < REPS(0); ++rep) {
        PHASE_IDS();
        LAS float* scr = (LAS float*)(lds + wave * 16384);
        const int gw = vcu * 8 + wave, NGW = G * 8;
        constexpr int I_WIN = 353 * 32, I_POOL = 256, I_WG = 32 * 64, I_WO = 32 * 64, NIT = I_WIN + I_POOL + I_WG + I_WO;
        for (int it = gw; it < NIT; it += NGW) {
            int r = it;
            if (r < I_WIN) { const int nb = r % 353, kb = r / 353; int col0, row0, nv = 32;
                if (nb < 224) { col0 = 32 * nb; row0 = 32 * nb; } else if (nb < 352) { col0 = 7184 + 32 * (nb - 224); row0 = 7168 + 32 * (nb - 224); } else { col0 = 7168; row0 = 11264; nv = 16; }
                transpose_item(args.in[2], INW, col0, nv, nullptr, nullptr, WIN_T, DM, row0, kb * 64, scr, lane); continue; }
            r -= I_WIN;
            if (r < I_POOL) { const int gi = r >> 6, q = r & 63, kb = q >> 4, nb = q & 15;
                transpose_item(args.in[3] + (size_t)gi * 256 * 512, 512, 32 * nb, 32, nullptr, args.in[4], WG_T, 2304, gi * 512 + 32 * nb, kb * 64, scr, lane); continue; }
            r -= I_POOL;
            if (r < I_WG) { const int nb = r & 63, kb = r >> 6; transpose_item<true>(args.in[8], DM, 32 * nb, 32, nullptr, nullptr, WG_T + 256, 2304, 32 * nb, kb * 64, scr, lane); continue; }
            r -= I_WG;
            { const int nb = r & 63, kb = r >> 6; transpose_item<true>(args.in[9], DM, 32 * nb, 32, nullptr, nullptr, WOUT_T, DM, 32 * nb, kb * 64, scr, lane); }
        }
        {
            constexpr int I_UP = 32 * 256, I_DN = 128 * 64;
            for (int it = gw; it < I_UP + I_DN; it += NGW) {
                if (it < I_UP) { const int nb = it & 255, kb = it >> 8; transpose_item<true>(args.in[11], FF, 32 * nb, 32, args.in[10], nullptr, WUP_T, DM, 32 * nb, kb * 64, scr, lane); }
                else { const int r = it - I_UP, nb = r & 63, kb = r >> 6; transpose_item<true>(args.in[12], DM, 32 * nb, 32, nullptr, nullptr, WDN_T, FF, 32 * nb, kb * 64, scr, lane); }
            }
        }
        const float* g1 = args.in[1];
        for (int m = gw; m < M; m += 2 * NGW) {
            const int m2 = m + NGW;
            const f32x4* xr = (const f32x4*)(x + (size_t)m * DM) + lane; const f32x4* xr2 = (const f32x4*)(x + (size_t)m2 * DM) + lane; f32x4 v[8], v2[8]; float s = 0.f, s2 = 0.f;
#pragma unroll
            for (int j = 0; j < 8; ++j) { v[j] = __builtin_nontemporal_load(xr + 64 * j); v2[j] = __builtin_nontemporal_load(xr2 + 64 * j); }
#pragma unroll
            for (int j = 0; j < 8; ++j) { s += (v[j].x * v[j].x + v[j].y * v[j].y) + (v[j].z * v[j].z + v[j].w * v[j].w); s2 += (v2[j].x * v2[j].x + v2[j].y * v2[j].y) + (v2[j].z * v2[j].z + v2[j].w * v2[j].w); }
            const float rstd = rsqrtf(wave_sum(s) * (1.0f / DM) + EPS), rstd2 = rsqrtf(wave_sum(s2) * (1.0f / DM) + EPS);
            u32x2* o8 = (u32x2*)(HB + (size_t)m * DM) + lane; u32x2* o82 = (u32x2*)(HB + (size_t)m2 * DM) + lane;
#pragma unroll
            for (int j = 0; j < 8; ++j) { const f32x4 gg = ((const f32x4*)g1)[64 * j + lane]; u32x2 w, w2;
                w.x = cvt_pk_bf16(v[j].x * rstd * gg.x, v[j].y * rstd * gg.y); w.y = cvt_pk_bf16(v[j].z * rstd * gg.z, v[j].w * rstd * gg.w); o8[64 * j] = w;
                w2.x = cvt_pk_bf16(v2[j].x * rstd2 * gg.x, v2[j].y * rstd2 * gg.y); w2.y = cvt_pk_bf16(v2[j].z * rstd2 * gg.z, v2[j].w * rstd2 * gg.w); o82[64 * j] = w2; }
        }
    }
    SEAM(0);
    if (IN(0) && IN(1)) {
        const unsigned ev = __builtin_amdgcn_readfirstlane(bst[2]), tk = __builtin_amdgcn_readfirstlane(bst[3]);
        if (ev != 0u && G == 256 && tk < 32u) { xloc = 1; vcu2 = (int)gbar.x * 32 + (int)tk; cid = (int)tk * 8 + (int)gbar.x; }
    }

    if (IN(1)) for (int rep = 0; rep < REPS(1); ++rep) {
        pg8::Gemm g{HB, WIN_T, DM, DM, DM, 0, 0}; pg8::StaticOrder S; S.init(M, NPROJ_T * 256, G, cid);
        EpiProj E{ws};
        pg8::gemm_phase<EpiProj>(lds, g, S, E, wave_s);
    }
    SEAM(1);

    if (IN(2)) for (int rep = 0; rep < REPS(2); ++rep) {
        {
            PHASE_IDS();
            LAS float* al = (LAS float*)lds; const LAS f32x4* al4 = (const LAS f32x4*)lds;
            LAS float* red = (LAS float*)(lds + 4096);
            LAS unsigned char* kimg = lds + 4096;
            const float* w_alpha = args.in[5]; const float* b_alpha = args.in[6];
            const int l16 = lane & 15, g4 = lane >> 4;
            for (int item = vcu2; item < M / 64; item += G) {
                __syncthreads();
                {   f32x4 pa[4];
#pragma unroll
                    for (int mt = 0; mt < 4; ++mt) pa[mt] = (f32x4){0.f, 0.f, 0.f, 0.f};
                    const bf16_t* hp = HB + (size_t)(item * 64 + l16) * DM + 256 * wave + 8 * g4;
                    const bf16_t* wp = WIN_T + (size_t)(11264 + l16) * DM + 256 * wave + 8 * g4;
#pragma unroll
                    for (int ks = 0; ks < 8; ++ks) {
                        const bf16x8 bfr = *(const bf16x8*)(wp + 32 * ks);
#pragma unroll
                        for (int mt = 0; mt < 4; ++mt) { const bf16x8 afr = *(const bf16x8*)(hp + (size_t)(16 * mt) * DM + 32 * ks);
                            pa[mt] = __builtin_amdgcn_mfma_f32_16x16x32_bf16(afr, bfr, pa[mt], 0, 0, 0); }
                    }
#pragma unroll
                    for (int mt = 0; mt < 4; ++mt)
#pragma unroll
                        for (int i = 0; i < 4; ++i) red[wave * 1024 + (16 * mt + 4 * g4 + i) * 16 + l16] = pa[mt][i];
                }
                __syncthreads();
                { float a0 = 0.f, a1 = 0.f;
#pragma unroll
                  for (int w8 = 0; w8 < 8; ++w8) { a0 += red[w8 * 1024 + tid]; a1 += red[w8 * 1024 + 512 + tid]; }
                  al[tid] = a0; al[512 + tid] = a1; }
                __syncthreads();
                for (int j = 0; j < 2; ++j) {
                    const int col = tid + 512 * j;
                    float w[16];
#pragma unroll
                    for (int r = 0; r < 16; ++r) w[r] = w_alpha[r * 1024 + col];
                    const float bias = b_alpha[col];
                    const bf16_t* kp = KB + (size_t)(item * 64) * 1024 + col;
                    float suf = 0.f;
                    for (int f8 = 7; f8 >= 0; --f8) {
                        float kd[8]; float kv[8];
#pragma unroll
                        for (int i = 0; i < 8; ++i) kv[i] = __uint_as_float(((unsigned)kp[(size_t)(f8 * 8 + i) * 1024]) << 16);
#pragma unroll
                        for (int i = 7; i >= 0; --i) { const int f = f8 * 8 + i;
                            const f32x4 a0 = al4[f * 4 + 0], a1 = al4[f * 4 + 1], a2 = al4[f * 4 + 2], a3 = al4[f * 4 + 3];
                            float z = bias;
                            z += a0.x * w[0] + a0.y * w[1] + a0.z * w[2] + a0.w * w[3];
                            z += a1.x * w[4] + a1.y * w[5] + a1.z * w[6] + a1.w * w[7];
                            z += a2.x * w[8] + a2.y * w[9] + a2.z * w[10] + a2.w * w[11];
                            z += a3.x * w[12] + a3.y * w[13] + a3.z * w[14] + a3.w * w[15];
                            const float ls = fminf(z, 0.f) - __logf(1.0f + __expf(-fabsf(z)));
                            kd[i] = kv[i] * __expf(suf);
                            suf += ls * 0.0625f; }
                        u32x4 o; o.x = cvt_pk_bf16(kd[0], kd[1]); o.y = cvt_pk_bf16(kd[2], kd[3]); o.z = cvt_pk_bf16(kd[4], kd[5]); o.w = cvt_pk_bf16(kd[6], kd[7]);
                        *(LAS u32x4*)(kimg + tid * 144 + f8 * 16) = o;
                    }
                    DEC[(size_t)item * 1024 + col] = __expf(suf);
                    __syncthreads();
                    {
                        u32x4* dst = (u32x4*)(KDT + (size_t)(item * 4 + 2 * j) * 256 * 64);
#pragma unroll
                        for (int i = 0; i < 8; ++i) { const int q = tid + 512 * i; dst[q] = *(const LAS u32x4*)(kimg + (q >> 3) * 144 + (q & 7) * 16); }
                    }
                    __syncthreads();
                }
            }
            __syncthreads();
        }
        {
            PHASE_IDS();
            for (int task = vcu2 * NTHREADS + tid; task < (M / 16) * 128; task += G * NTHREADS) {
                const int run = task >> 7, c8 = task & 127, ch = c8 * 8, gi = ch >> 8;
                const int t0 = run * 16, tp = t0 & (SEQ - 1);
                const bf16_t* up = UB + (size_t)t0 * 1024 + ch; bf16_t* dp = DB + (size_t)t0 * 1024 + ch;
                if (gi == 0) pool_task<2>(up, dp, tp); else if (gi == 1) pool_task<4>(up, dp, tp); else if (gi == 2) pool_task<8>(up, dp, tp); else pool_task<16>(up, dp, tp);
            }
        }
    }
    SEAM(2);

    if (IN(3)) for (int rep = 0; rep < REPS(3); ++rep) {
        PHASE_IDS();
        constexpr int KTP = 72, QP = 264, VTP = 72, OPP = 68;
        LAS bf16_t* KT = (LAS bf16_t*)lds;
        LAS bf16_t* QS = (LAS bf16_t*)(lds + 36864);
        LAS bf16_t* VT = (LAS bf16_t*)(lds + 36864 + 33792);
        LAS float* DC = (LAS float*)(lds + 36864 + 33792 + 9216);
        LAS float* OP = (LAS float*)(lds + 36864 + 33792 + 9216 + 1024);
        const int kh = wave >> 2, ng = wave & 3, l16 = lane & 15, g4 = lane >> 4;
        for (int wi = vcu2; wi < NB * 4 * 8; wi += G) {
            const int b = wi >> 5, hh = (wi >> 3) & 3, es = wi & 7;
            f32x4 S[8];
#pragma unroll
            for (int t = 0; t < 8; ++t) S[t] = (f32x4){0.f, 0.f, 0.f, 0.f};
            u32x4 rk[4], rq[4], rv, rgn, rgc; float rd = 0.f;
            float ngv[8];
            { const float* ngp = args.in[7] + hh * 512 + es * 64 + (tid & 7) * 8; const f32x4 n0 = *(const f32x4*)ngp, n1 = *(const f32x4*)(ngp + 4);
              ngv[0] = n0.x; ngv[1] = n0.y; ngv[2] = n0.z; ngv[3] = n0.w; ngv[4] = n1.x; ngv[5] = n1.y; ngv[6] = n1.z; ngv[7] = n1.w; }
#define SCAN_LOAD(c) do { const int _ci = b * 32 + (c); const size_t _row0 = (size_t)_ci * 64; \
            const u32x4* _kp = (const u32x4*)(KDT + (size_t)(_ci * 4 + hh) * 256 * 64); \
            _Pragma("unroll") for (int _i = 0; _i < 4; ++_i) rk[_i] = _kp[tid + 512 * _i]; \
            _Pragma("unroll") for (int _i = 0; _i < 4; ++_i) { const int _q = tid + 512 * _i, _f = _q >> 5, _p = _q & 31; rq[_i] = *(const u32x4*)(QB + (_row0 + _f) * 1024 + hh * 256 + _p * 8); } \
            rv = *(const u32x4*)(VB + (_row0 + lane) * 2048 + hh * 512 + es * 64 + wave * 8); \
            rgn = *(const u32x4*)(GB + (_row0 + (tid >> 3)) * 2048 + hh * 512 + es * 64 + (tid & 7) * 8); \
            if (tid < 256) rd = DEC[(size_t)_ci * 1024 + hh * 256 + tid]; } while (0)
            SCAN_LOAD(0);
            for (int c = 0; c < 32; ++c) {
#pragma unroll
                for (int i = 0; i < 4; ++i) { const int q = tid + 512 * i; *(LAS u32x4*)((LAS unsigned char*)KT + (q >> 3) * (KTP * 2) + (q & 7) * 16) = rk[i]; }
#pragma unroll
                for (int i = 0; i < 4; ++i) { const int q = tid + 512 * i; *(LAS u32x4*)((LAS unsigned char*)QS + (q >> 5) * (QP * 2) + (q & 31) * 16) = rq[i]; }
                { LAS bf16_t* vp = VT + (wave * 8) * VTP + lane;
                  vp[0 * VTP] = (bf16_t)(rv.x & 0xffffu); vp[1 * VTP] = (bf16_t)(rv.x >> 16); vp[2 * VTP] = (bf16_t)(rv.y & 0xffffu); vp[3 * VTP] = (bf16_t)(rv.y >> 16);
                  vp[4 * VTP] = (bf16_t)(rv.z & 0xffffu); vp[5 * VTP] = (bf16_t)(rv.z >> 16); vp[6 * VTP] = (bf16_t)(rv.w & 0xffffu); vp[7 * VTP] = (bf16_t)(rv.w >> 16); }
                if (tid < 256) DC[tid] = rd;
                rgc = rgn;
                __syncthreads();
                if (c + 1 < 32) SCAN_LOAD(c + 1);
                const bf16x8 bv0 = *(const LAS bf16x8*)(VT + (16 * ng + l16) * VTP + 8 * g4), bv1 = *(const LAS bf16x8*)(VT + (16 * ng + l16) * VTP + 32 + 8 * g4);
#pragma unroll
                for (int t = 0; t < 8; ++t) {
                    const f32x4 dc = *(const LAS f32x4*)(DC + 128 * kh + 16 * t + 4 * g4);
                    const bf16x8 a0 = *(const LAS bf16x8*)(KT + (128 * kh + 16 * t + l16) * KTP + 8 * g4), a1 = *(const LAS bf16x8*)(KT + (128 * kh + 16 * t + l16) * KTP + 32 + 8 * g4);
                    S[t] = S[t] * dc;
                    S[t] = __builtin_amdgcn_mfma_f32_16x16x32_bf16(a0, bv0, S[t], 0, 0, 0);
                    S[t] = __builtin_amdgcn_mfma_f32_16x16x32_bf16(a1, bv1, S[t], 0, 0, 0);
                }
                f32x4 o[4];
#pragma unroll
                for (int mt = 0; mt < 4; ++mt) o[mt] = (f32x4){0.f, 0.f, 0.f, 0.f};
#pragma unroll
                for (int s = 0; s < 4; ++s) {
                    u32x4 bw; bw.x = cvt_pk_bf16(S[2 * s][0], S[2 * s][1]); bw.y = cvt_pk_bf16(S[2 * s][2], S[2 * s][3]); bw.z = cvt_pk_bf16(S[2 * s + 1][0], S[2 * s + 1][1]); bw.w = cvt_pk_bf16(S[2 * s + 1][2], S[2 * s + 1][3]);
                    const bf16x8 bs = __builtin_bit_cast(bf16x8, bw);
#pragma unroll
                    for (int mt = 0; mt < 4; ++mt) {
                        const LAS bf16_t* qp = QS + (16 * mt + l16) * QP + 128 * kh + 32 * s + 4 * g4;
                        const u32x2 q0 = *(const LAS u32x2*)qp, q1 = *(const LAS u32x2*)(qp + 16);
                        u32x4 aw; aw.x = q0.x; aw.y = q0.y; aw.z = q1.x; aw.w = q1.y;
                        o[mt] = __builtin_amdgcn_mfma_f32_16x16x32_bf16(__builtin_bit_cast(bf16x8, aw), bs, o[mt], 0, 0, 0);
                    }
                }
#pragma unroll
                for (int mt = 0; mt < 4; ++mt)
#pragma unroll
                    for (int i = 0; i < 4; ++i) OP[kh * (64 * OPP) + (16 * mt + 4 * g4 + i) * OPP + 16 * ng + l16] = o[mt][i];
                __syncthreads();
                {
                    const int f = tid >> 3, d8 = (tid & 7) * 8;
                    const f32x4 p0 = *(const LAS f32x4*)(OP + f * OPP + d8), p1 = *(const LAS f32x4*)(OP + f * OPP + d8 + 4);
                    const f32x4 r0 = *(const LAS f32x4*)(OP + 64 * OPP + f * OPP + d8), r1 = *(const LAS f32x4*)(OP + 64 * OPP + f * OPP + d8 + 4);
                    const f32x4 v0 = p0 + r0, v1 = p1 + r1;
                    float ss = (v0[0] * v0[0] + v0[1] * v0[1]) + (v0[2] * v0[2] + v0[3] * v0[3]) + (v1[0] * v1[0] + v1[1] * v1[1]) + (v1[2] * v1[2] + v1[3] * v1[3]);
                    ss += __shfl_xor(ss, 1); ss += __shfl_xor(ss, 2); ss += __shfl_xor(ss, 4);
                    const size_t row = (size_t)(b * 32 + c) * 64 + f;
                    if ((tid & 7) == 0) SSP[row * 32 + hh * 8 + es] = ss;
                    const float gv[8] = {bflo(rgc.x), bfhi(rgc.x), bflo(rgc.y), bfhi(rgc.y), bflo(rgc.z), bfhi(rgc.z), bflo(rgc.w), bfhi(rgc.w)};
                    float og[8] = {v0[0], v0[1], v0[2], v0[3], v1[0], v1[1], v1[2], v1[3]};
#pragma unroll
                    for (int e = 0; e < 8; ++e) og[e] *= ngv[e] * gv[e] * fast_sigmoid(gv[e]);
                    u32x4 w; w.x = cvt_pk_bf16(og[0], og[1]); w.y = cvt_pk_bf16(og[2], og[3]); w.z = cvt_pk_bf16(og[4], og[5]); w.w = cvt_pk_bf16(og[6], og[7]);
                    *(u32x4*)(ONB + row * 2048 + hh * 512 + es * 64 + d8) = w;
                }
            }
#undef SCAN_LOAD
            __syncthreads();
        }
    }
    do { if (IN(3) && IN(5)) { xcd_barrier(gbar, MK_TID(wave_s) == 0, xloc != 0); } } while (0);

    if (IN(5)) for (int rep = 0; rep < REPS(5); ++rep) {
        pg8::StaticOrder S; S.init(M, DM, G, cid);
        {
            PHASE_IDS(); pg8::Unit u0; S.next(0, u0);
            if (tid < 256) { const f32x4* sp = (const f32x4*)(SSP + (size_t)(u0.pm * 256 + tid) * 32); float r[4];
#pragma unroll
                for (int h4 = 0; h4 < 4; ++h4) { const f32x4 s0 = sp[2 * h4], s1 = sp[2 * h4 + 1]; r[h4] = rsqrtf((((s0.x + s0.y) + (s0.z + s0.w)) + ((s1.x + s1.y) + (s1.z + s1.w))) * (1.0f / 512.0f) + EPS); }
                *(LAS f32x4*)(lds + pg8::STAGE_BYTES + tid * 16) = (f32x4){r[0] / r[1], r[1] / r[2], r[2] / r[3], r[3]}; }
            __syncthreads();
        }
        { pg8::Gemm g{ONB, WG_T, 2304, DM, 2304, 0, 0, DB, 1024}; EpiMixF E{GATES, MIXED, (const LAS float*)(lds + pg8::STAGE_BYTES)};
          pg8::gemm_phase<EpiMixF, true, pg8::StaticOrder, true, true>(lds, g, S, E, wave_s); }
    }
    SEAM(5);

    if (IN(6)) {
        pg8::Gemm g{MIXED, WOUT_T, DM, DM, DM, 0, 0}; pg8::StaticOrder S; S.init(M, DM, G, cid);
        EpiRes<true> E{x, X1N, RSS1};
        pg8::gemm_phase<EpiRes<true>>(lds, g, S, E, wave_s);
    }
    SEAM(6);

    if (IN(7)) for (int rep = 0; rep < REPS(7); ++rep) {
        pg8::Gemm g{X1N, WUP_T, DM, DM, DM, 0, 0}; pg8::StaticOrder S; S.init(M, FF, G, cid);
        EpiUp E{RSS1, UPACT};
        pg8::gemm_phase<EpiUp>(lds, g, S, E, wave_s);
#if PROBE_K == 1
        { EpiNull E0{RSS1}; pg8::gemm_phase<EpiNull>(lds, g, S, E0, wave_s); }
#elif PROBE_K == 2
        { FixedOrder S2; S2.init(M, FF, G, cid); EpiNull E0{RSS1}; pg8::gemm_phase<EpiNull, true, FixedOrder>(lds, g, S2, E0, wave_s); }
#endif
    }
    SEAM(7);

    if (IN(8)) {
        pg8::Gemm g{UPACT, WDN_T, FF, FF, FF, 0, 0}; pg8::StaticOrder S; S.init(M, DM, G, cid, 4);
        EpiRes<false> E{nullptr, X1N, RSS2};
        pg8::gemm_phase<EpiRes<false>>(lds, g, S, E, wave_s);
    }
    SEAM(8);

    if (IN(9)) {
        PHASE_IDS();
        const float* gf = args.in[13];
        for (int rr = 0; rr < (M / 256) / 8; rr += 2) {
            const int row0 = (M / 256) * vcu2 + wave + 8 * rr, row1 = row0 + 8;
            const u32x4* p0 = (const u32x4*)(X1N + (size_t)row0 * DM) + lane; const u32x4* p1 = (const u32x4*)(X1N + (size_t)row1 * DM) + lane;
            u32x4 a[4], b[4];
#pragma unroll
            for (int q = 0; q < 4; ++q) { a[q] = p0[64 * q]; b[q] = p1[64 * q]; }
            float sa = 0.f, sb = 0.f;
#pragma unroll
            for (int q = 0; q < 4; ++q) {
                sa += (bflo(a[q].x) * bflo(a[q].x) + bfhi(a[q].x) * bfhi(a[q].x)) + (bflo(a[q].y) * bflo(a[q].y) + bfhi(a[q].y) * bfhi(a[q].y)) + (bflo(a[q].z) * bflo(a[q].z) + bfhi(a[q].z) * bfhi(a[q].z)) + (bflo(a[q].w) * bflo(a[q].w) + bfhi(a[q].w) * bfhi(a[q].w));
                sb += (bflo(b[q].x) * bflo(b[q].x) + bfhi(b[q].x) * bfhi(b[q].x)) + (bflo(b[q].y) * bflo(b[q].y) + bfhi(b[q].y) * bfhi(b[q].y)) + (bflo(b[q].z) * bflo(b[q].z) + bfhi(b[q].z) * bfhi(b[q].z)) + (bflo(b[q].w) * bflo(b[q].w) + bfhi(b[q].w) * bfhi(b[q].w)); }
            const float ra = rsqrtf(wave_sum(sa) * (1.0f / DM) + EPS), rb = rsqrtf(wave_sum(sb) * (1.0f / DM) + EPS);
#pragma unroll
            for (int q = 0; q < 4; ++q) { const int c8 = 8 * (lane + 64 * q); const f32x4 g0 = *(const f32x4*)(gf + c8), g1 = *(const f32x4*)(gf + c8 + 4);
                float* o0 = args.out + (size_t)row0 * DM + c8; float* o1 = args.out + (size_t)row1 * DM + c8;
                *(f32x4*)o0 = (f32x4){bflo(a[q].x) * ra * g0.x, bfhi(a[q].x) * ra * g0.y, bflo(a[q].y) * ra * g0.z, bfhi(a[q].y) * ra * g0.w};
                *(f32x4*)(o0 + 4) = (f32x4){bflo(a[q].z) * ra * g1.x, bfhi(a[q].z) * ra * g1.y, bflo(a[q].w) * ra * g1.z, bfhi(a[q].w) * ra * g1.w};
                *(f32x4*)o1 = (f32x4){bflo(b[q].x) * rb * g0.x, bfhi(b[q].x) * rb * g0.y, bflo(b[q].y) * rb * g0.z, bfhi(b[q].y) * rb * g0.w};
                *(f32x4*)(o1 + 4) = (f32x4){bflo(b[q].z) * rb * g1.x, bfhi(b[q].z) * rb * g1.y, bflo(b[q].w) * rb * g1.z, bfhi(b[q].w) * rb * g1.w}; }
        }
    }
#undef IN
#undef SEAM
}

extern "C" void kernel_launch(void* const* d_in, const int* in_sizes, int n_in, void* d_out, int out_size, void* d_ws, size_t ws_size, hipStream_t stream) {
    static int grid = 0;
    if (grid == 0) {
        if (n_in != 14 || out_size != M * DM || ws_size < WS_END) { fprintf(stderr, "kernel_launch: unexpected shapes (n_in %d out %d ws %zu)\n", n_in, out_size, ws_size); grid = -1; return; }
        int dev = 0, cus = 0, per_cu = 0;
        (void)hipGetDevice(&dev); (void)hipDeviceGetAttribute(&cus, hipDeviceAttributeMultiprocessorCount, dev);
        if (hipFuncSetAttribute((const void*)mk_fwd, hipFuncAttributeMaxDynamicSharedMemorySize, LDS_BYTES) != hipSuccess) { fprintf(stderr, "kernel_launch: hipFuncSetAttribute failed\n"); grid = -1; return; }
        if (hipOccupancyMaxActiveBlocksPerMultiprocessor(&per_cu, (const void*)mk_fwd, NTHREADS, LDS_BYTES) != hipSuccess || per_cu < 1) per_cu = 1;
        (void)hipGetLastError();
        grid = cus * per_cu;
        if (grid > 256) grid = 256;
        fprintf(stderr, "kernel_launch: grid %d (cus %d per_cu %d) ws %zu\n", grid, cus, per_cu, ws_size);
    }
    if (grid < 0) return;
    if (hipMemsetAsync(d_ws, 0, WS_ZERO_BYTES, stream) != hipSuccess) { fprintf(stderr, "kernel_launch: hipMemsetAsync failed\n"); return; }
    Args a{};
    for (int i = 0; i < 14; ++i) a.in[i] = (const float*)d_in[i];
    a.out = (float*)d_out; a.ws = (unsigned char*)d_ws;
#if MK_N_LAUNCHES == 1
    a.ph_lo = 0; a.ph_hi = N_PHASES;
    void* kargs[] = {&a};
    hipError_t e = hipLaunchCooperativeKernel((const void*)mk_fwd, dim3(grid), dim3(NTHREADS), kargs, LDS_BYTES, stream);
    if (e != hipSuccess) fprintf(stderr, "kernel_launch: cooperative launch failed: %s (grid %d)\n", hipGetErrorString(e), grid);
#else
    for (int p = 0; p < N_PHASES; ++p) { a.ph_lo = p; a.ph_hi = p + 1; hipLaunchKernelGGL(mk_fwd, dim3(grid), dim3(NTHREADS), LDS_BYTES, stream, a); }
#endif
}
```
